# Optimizing an MI355X kernel written in HIP

```python
import math
import jax, jax.numpy as jnp
from jax import lax
import numpy as np

D_MODEL = 1024
BATCH = 2
SEQ = 8192
DEPTH = 2

SSM_GROUP = 16
SSM_GROUPS = 40
SSM_WIDTH = SSM_GROUP * SSM_GROUPS
SSM_STATE = 64
ATT_HEADS = 6
ATT_HEAD_DIM = 64
ATT_WIDTH = ATT_HEADS * ATT_HEAD_DIM
MIX_IN_EVEN = SSM_WIDTH + 3 * ATT_WIDTH
MIX_OUT_EVEN = SSM_WIDTH + ATT_WIDTH
DILATED_PATTERNS = ((128, 1), (512, 4), (2048, 16))
ATT_BLK = 128
CONV_WIDTH = D_MODEL
CONV_TAPS = 3
N_GROUPS = 4
EXPERTS_PER_GROUP = 8
N_EXPERTS = N_GROUPS * EXPERTS_PER_GROUP
TOP_K_IN_GROUP = 2
D_EXPERT = 512
MOE_BLK = 256

RMS_EPS = 1e-6
NEG_INF = -1e30
N_EVEN = (DEPTH + 1) // 2
N_ODD = DEPTH // 2

kernel_name = 'hybrid_s5_dilated_attn_shortconv_hier_moe'


def rms_norm(x, g):
    x32 = x.astype(jnp.float32)
    y = x32 * lax.rsqrt(jnp.mean(x32 * x32, axis=-1, keepdims=True) + RMS_EPS)
    return (y * g.astype(jnp.float32)).astype(x.dtype)


def alibi_slopes(n_heads):
    return jnp.asarray([2.0 ** (-8.0 * (h + 1) / n_heads) for h in range(n_heads)], jnp.float32)


def _ssm_combine(e1, e2):
    a1, b1 = e1
    a2, b2 = e2
    return a1 * a2, a2 * b1 + b2


def s5_mixer(u, a_re, a_im, b_re, b_im, c_re, c_im, d_skip, log_step, w_glu, b_glu):
    bsz, s_len, _ = u.shape
    f32 = jnp.float32
    u32 = u.astype(f32).reshape(bsz, s_len, SSM_GROUPS, SSM_GROUP)
    lam = lax.complex(a_re.astype(f32), a_im.astype(f32))
    step = jnp.exp(log_step.astype(f32))[:, None]
    lam_bar = jnp.exp(lam * step)
    b_bar = ((lam_bar - 1.0) / lam)[..., None] * lax.complex(b_re.astype(f32), b_im.astype(f32))
    bu = jnp.einsum('bsgh,gph->bsgp', u32.astype(jnp.complex64), b_bar)
    a = jnp.broadcast_to(lam_bar, (1, s_len) + lam_bar.shape)
    _, states = lax.associative_scan(_ssm_combine, (a, bu), axis=1)
    c = lax.complex(c_re.astype(f32), c_im.astype(f32))
    y = jnp.einsum('bsgp,ghp->bsgh', states, c).real + d_skip.astype(f32).reshape(SSM_GROUPS, SSM_GROUP) * u32
    y = jax.nn.gelu(y.reshape(bsz, s_len, SSM_WIDTH))
    y = y * jax.nn.sigmoid(y @ w_glu.astype(f32) + b_glu.astype(f32))
    return y.astype(u.dtype)


def _to_sub(t, s_pad, dil):
    bsz, s_len, nh, e = t.shape
    t = jnp.pad(t, ((0, 0), (0, s_pad - s_len), (0, 0), (0, 0)))
    return t.reshape(bsz, s_pad // dil, dil, nh, e).transpose(0, 2, 3, 1, 4)


def _from_sub(t, s_len):
    bsz, dil, nh = t.shape[:3]
    rest = t.shape[5:]
    t = t.reshape((bsz, dil, nh, -1) + rest)
    perm = (0, 3, 1, 2) + tuple(range(4, 4 + len(rest)))
    t = t.transpose(perm)
    return t.reshape((bsz, -1, nh) + rest)[:, :s_len]


def dilated_branch(q, k, v, slopes, window, dil):
    bsz, s_len, nh, dh = q.shape
    steps = window // dil
    sub_len = -(-s_len // dil)
    sub_pad = -(-sub_len // ATT_BLK) * ATT_BLK
    s_pad = sub_pad * dil
    nb = sub_pad // ATT_BLK
    qb = _to_sub(q, s_pad, dil).reshape(bsz, dil, nh, nb, ATT_BLK, dh)

    def kv_blocks(t):
        t = jnp.pad(_to_sub(t, s_pad, dil), ((0, 0), (0, 0), (0, 0), (ATT_BLK, 0), (0, 0)))
        t = t.reshape(bsz, dil, nh, nb + 1, ATT_BLK, dh)
        return jnp.concatenate([t[:, :, :, :-1], t[:, :, :, 1:]], axis=4)

    kb, vb = kv_blocks(k), kv_blocks(v)
    s = jnp.einsum('bdhnqe,bdhnke->bdhnqk', qb, kb, preferred_element_type=jnp.float32)
    qi = jnp.arange(ATT_BLK)[:, None]
    kj = jnp.arange(2 * ATT_BLK)[None, :]
    diff = qi + ATT_BLK - kj
    blk_start = (jnp.arange(nb) * ATT_BLK)[:, None, None]
    valid = (diff >= 0) & (diff <= steps) & (blk_start + kj - ATT_BLK >= 0)
    dist = (diff * dil).astype(jnp.float32)
    bias = -slopes[:, None, None, None] * dist[None, None]
    s = jnp.where(valid, s + bias, NEG_INF)
    m = jnp.max(s, axis=-1, keepdims=True)
    p = jnp.where(valid, jnp.exp(s - m), 0.0)
    l = jnp.sum(p, axis=-1)
    o = jnp.einsum('bdhnqk,bdhnke->bdhnqe', p, vb.astype(jnp.float32)) / l[..., None]
    return _from_sub(o, s_len), _from_sub(m[..., 0], s_len), _from_sub(l, s_len)


def dilated_attention(q, k, v):
    slopes = alibi_slopes(ATT_HEADS)
    res = [dilated_branch(q, k, v, slopes, w, d) for (w, d) in DILATED_PATTERNS]
    o_all = jnp.stack([r[0] for r in res])
    m_all = jnp.stack([r[1] for r in res])
    l_all = jnp.stack([r[2] for r in res])
    wts = l_all * jnp.exp(m_all - jnp.max(m_all, axis=0, keepdims=True))
    out = jnp.sum(wts[..., None] * o_all, axis=0) / jnp.sum(wts, axis=0)[..., None]
    return out.astype(q.dtype)


def even_mixer(h, w_in, a_re, a_im, b_re, b_im, c_re, c_im, d_skip, log_step, w_glu, b_glu, q_norm, k_norm, w_out):
    bsz, s_len, _ = h.shape
    proj = h @ w_in
    u = proj[..., :SSM_WIDTH]
    q = proj[..., SSM_WIDTH:SSM_WIDTH + ATT_WIDTH].reshape(bsz, s_len, ATT_HEADS, ATT_HEAD_DIM)
    k = proj[..., SSM_WIDTH + ATT_WIDTH:SSM_WIDTH + 2 * ATT_WIDTH].reshape(bsz, s_len, ATT_HEADS, ATT_HEAD_DIM)
    v = proj[..., SSM_WIDTH + 2 * ATT_WIDTH:].reshape(bsz, s_len, ATT_HEADS, ATT_HEAD_DIM)
    q = rms_norm(q, q_norm) * (ATT_HEAD_DIM ** -0.5)
    k = rms_norm(k, k_norm)
    attn = dilated_attention(q, k, v).reshape(bsz, s_len, ATT_WIDTH)
    ssm = s5_mixer(u, a_re, a_im, b_re, b_im, c_re, c_im, d_skip, log_step, w_glu, b_glu)
    return jnp.concatenate([ssm, attn], axis=-1) @ w_out


def conv_mixer(h, w_in, conv_w, w_out):
    proj = h @ w_in
    b_gate = proj[..., :CONV_WIDTH]
    c_gate = proj[..., CONV_WIDTH:2 * CONV_WIDTH]
    z = proj[..., 2 * CONV_WIDTH:]
    zc = c_gate * z
    zc = lax.conv_general_dilated(zc, conv_w.astype(zc.dtype)[:, None, :], window_strides=(1,),
                                  padding=((CONV_TAPS - 1, 0),), dimension_numbers=('NWC', 'WIO', 'NWC'),
                                  feature_group_count=CONV_WIDTH)
    return (b_gate * zc) @ w_out


def hier_moe(h, w_rg, b_rg, w_re, b_re, w_g, w_u, w_d):
    bsz, s_len, d = h.shape
    n_tok = bsz * s_len
    f32 = jnp.float32
    x2 = h.reshape(n_tok, d)
    g_prob = jax.nn.softmax((x2 @ w_rg).astype(f32) + b_rg.astype(f32), axis=-1)
    g_w, grp = lax.top_k(g_prob, 1)
    grp = grp[:, 0]
    e_logits = ((x2 @ w_re).astype(f32) + b_re.astype(f32)).reshape(n_tok, N_GROUPS, EXPERTS_PER_GROUP)
    e_logits = jnp.take_along_axis(e_logits, grp[:, None, None], axis=1)[:, 0]
    top_p, top_i = lax.top_k(jax.nn.softmax(e_logits, axis=-1), TOP_K_IN_GROUP)
    gate = g_w * top_p / jnp.sum(top_p, axis=-1, keepdims=True)
    expert = grp[:, None] * EXPERTS_PER_GROUP + top_i

    n = n_tok * TOP_K_IN_GROUP
    e_flat = expert.reshape(n).astype(jnp.int32)
    t_flat = jnp.repeat(jnp.arange(n_tok, dtype=jnp.int32), TOP_K_IN_GROUP)
    w_flat = gate.reshape(n)
    order = jnp.argsort(e_flat)
    e_s, t_s, w_s = e_flat[order], t_flat[order], w_flat[order]
    counts = jnp.bincount(e_flat, length=N_EXPERTS)
    starts = jnp.cumsum(counts) - counts
    padded = (counts + MOE_BLK - 1) // MOE_BLK * MOE_BLK
    pends = jnp.cumsum(padded)
    pstarts = pends - padded
    dest = pstarts[e_s] + jnp.arange(n, dtype=jnp.int32) - starts[e_s]
    n_rows = (-(-n // MOE_BLK) + N_EXPERTS) * MOE_BLK
    n_blocks = n_rows // MOE_BLK
    row_tok = jnp.full((n_rows,), n_tok, jnp.int32).at[dest].set(t_s)
    row_w = jnp.zeros((n_rows,), f32).at[dest].set(w_s)
    blk_e = jnp.minimum(jnp.searchsorted(pends, jnp.arange(n_blocks, dtype=jnp.int32) * MOE_BLK, side='right'),
                        N_EXPERTS - 1)
    x_pad = jnp.concatenate([x2, jnp.zeros((1, d), x2.dtype)], axis=0)

    def expert_block(args):
        tok, e = args
        xb = x_pad[tok]
        hb = jax.nn.silu(xb @ w_g[e]) * (xb @ w_u[e])
        return hb @ w_d[e]

    y_rows = lax.map(expert_block, (row_tok.reshape(n_blocks, MOE_BLK), blk_e))
    y = jax.ops.segment_sum(y_rows.reshape(n_rows, d).astype(f32) * row_w[:, None], row_tok,
                            num_segments=n_tok + 1)[:n_tok]
    return y.astype(h.dtype).reshape(bsz, s_len, d)


def setup_inputs(seed: int = 0) -> dict:
    key = jax.random.key(seed)
    ks = jax.random.split(key, 32)
    f32 = jnp.float32
    nrm = lambda k, shape, scale: jax.random.normal(k, shape, f32) * scale
    d = D_MODEL
    a_im_base = jnp.pi * jnp.arange(SSM_STATE, dtype=f32)
    return {
        'x': nrm(ks[0], (BATCH, SEQ, d), 1.0),
        'norm_mix': 1.0 + nrm(ks[1], (DEPTH, d), 0.02),
        'norm_ffn': 1.0 + nrm(ks[2], (DEPTH, d), 0.02),
        'w_in_even': nrm(ks[3], (N_EVEN, d, MIX_IN_EVEN), d ** -0.5),
        'ssm_a_re': -0.5 + nrm(ks[4], (N_EVEN, SSM_GROUPS, SSM_STATE), 0.01),
        'ssm_a_im': a_im_base + nrm(ks[5], (N_EVEN, SSM_GROUPS, SSM_STATE), 0.01),
        'ssm_b_re': nrm(ks[6], (N_EVEN, SSM_GROUPS, SSM_STATE, SSM_GROUP), (2 * SSM_GROUP) ** -0.5),
        'ssm_b_im': nrm(ks[7], (N_EVEN, SSM_GROUPS, SSM_STATE, SSM_GROUP), (2 * SSM_GROUP) ** -0.5),
        'ssm_c_re': nrm(ks[8], (N_EVEN, SSM_GROUPS, SSM_GROUP, SSM_STATE), SSM_STATE ** -0.5),
        'ssm_c_im': nrm(ks[9], (N_EVEN, SSM_GROUPS, SSM_GROUP, SSM_STATE), SSM_STATE ** -0.5),
        'ssm_d': nrm(ks[10], (N_EVEN, SSM_WIDTH), 1.0),
        'ssm_log_step': jax.random.uniform(ks[11], (N_EVEN, SSM_GROUPS), f32, math.log(1e-3), math.log(1e-1)),
        'w_glu': nrm(ks[12], (N_EVEN, SSM_WIDTH, SSM_WIDTH), SSM_WIDTH ** -0.5),
        'b_glu': nrm(ks[13], (N_EVEN, SSM_WIDTH), 0.01),
        'q_norm': 1.0 + nrm(ks[14], (N_EVEN, ATT_HEAD_DIM), 0.02),
        'k_norm': 1.0 + nrm(ks[15], (N_EVEN, ATT_HEAD_DIM), 0.02),
        'w_out_even': nrm(ks[16], (N_EVEN, MIX_OUT_EVEN, d), MIX_OUT_EVEN ** -0.5),
        'w_in_conv': nrm(ks[17], (N_ODD, d, 3 * CONV_WIDTH), d ** -0.5),
        'conv_w': nrm(ks[18], (N_ODD, CONV_TAPS, CONV_WIDTH), CONV_TAPS ** -0.5),
        'w_out_conv': nrm(ks[19], (N_ODD, CONV_WIDTH, d), CONV_WIDTH ** -0.5),
        'w_router_group': nrm(ks[20], (DEPTH, d, N_GROUPS), d ** -0.5),
        'b_router_group': nrm(ks[21], (DEPTH, N_GROUPS), 0.01),
        'w_router_expert': nrm(ks[22], (DEPTH, d, N_EXPERTS), d ** -0.5),
        'b_router_expert': nrm(ks[23], (DEPTH, N_EXPERTS), 0.01),
        'w_expert_gate': nrm(ks[24], (DEPTH, N_EXPERTS, d, D_EXPERT), d ** -0.5),
        'w_expert_up': nrm(ks[25], (DEPTH, N_EXPERTS, d, D_EXPERT), d ** -0.5),
        'w_expert_down': nrm(ks[26], (DEPTH, N_EXPERTS, D_EXPERT, d), D_EXPERT ** -0.5),
    }


def reference(x, norm_mix, norm_ffn, w_in_even, ssm_a_re, ssm_a_im, ssm_b_re, ssm_b_im, ssm_c_re, ssm_c_im,
              ssm_d, ssm_log_step, w_glu, b_glu, q_norm, k_norm, w_out_even, w_in_conv, conv_w, w_out_conv,
              w_router_group, b_router_group, w_router_expert, b_router_expert, w_expert_gate, w_expert_up,
              w_expert_down):
    h = x
    for layer in range(DEPTH):
        hn = rms_norm(h, norm_mix[layer])
        i = layer // 2
        if layer % 2 == 0:
            mix = even_mixer(hn, w_in_even[i], ssm_a_re[i], ssm_a_im[i], ssm_b_re[i], ssm_b_im[i], ssm_c_re[i],
                             ssm_c_im[i], ssm_d[i], ssm_log_step[i], w_glu[i], b_glu[i], q_norm[i], k_norm[i],
                             w_out_even[i])
        else:
            mix = conv_mixer(hn, w_in_conv[i], conv_w[i], w_out_conv[i])
        h = h + mix
        h = h + hier_moe(rms_norm(h, norm_ffn[layer]), w_router_group[layer], b_router_group[layer],
                         w_router_expert[layer], b_router_expert[layer], w_expert_gate[layer],
                         w_expert_up[layer], w_expert_down[layer])
    return h
```

```cpp
#include <hip/hip_runtime.h>
#include <cstdio>
#include <cstdint>

#ifndef NLAUNCH
#define NLAUNCH 1
#endif

#ifndef DRY_MASK
#define DRY_MASK 0u
#endif
#ifndef DRY_KIND
#define DRY_KIND 1
#endif
#ifndef REPEAT_MASK
#define REPEAT_MASK 0u
#endif
#define LAS __attribute__((address_space(3)))
typedef unsigned short bf16_t;
typedef short bf16x8 __attribute__((ext_vector_type(8)));
typedef float f32x4 __attribute__((ext_vector_type(4)));
typedef unsigned u32x4 __attribute__((ext_vector_type(4)));
typedef unsigned u32x2 __attribute__((ext_vector_type(2)));

namespace {
constexpr int D = 1024, NB = 2, S = 8192, T = NB * S;
constexpr int SSMW = 640, NG = 40, GS = 16, NS = 64;
constexpr int AH = 6, HD = 64, AW = 384, MIXIN = 1792, GLUN = 768, CONVN = 3072;
constexpr int NE = 32, DE = 512, CAP = T, MAXROWS = 40960;
constexpr float EPS = 1e-6f;
constexpr int NPHASE = 17;
constexpr int FILL_G1 = 18432, FILL_G2 = 6144;
constexpr int FILL_IN = 3072, FILL_GLU = 3072;
enum { PH_PRO = 0, PH_INPROJ, PH_ATTN, PH_SSMY, PH_GLU, PH_OUT0, PH_RT0, PH_G1_0, PH_G2_0, PH_CMB0, PH_CONVIN, PH_CONV, PH_CONVOUT, PH_RT1, PH_G1_1, PH_G2_1, PH_CMB1 };
#ifndef DBG
#define DBG 0
#endif
#define DBG_TOL 1e-4f

constexpr size_t MiB = 1u << 20;
constexpr size_t WS_CTL = 0, CTL_BYTES = 256 * 1024;
constexpr size_t WS_RSMIX = 1 * MiB, WS_RSFFN = 1 * MiB + 512 * 1024;
constexpr size_t WS_TOKROW = 2 * MiB;
constexpr size_t WS_LIST = 3 * MiB, WS_GATEL = 5 * MiB;
constexpr size_t WS_WRT = 7 * MiB;
constexpr size_t WS_WIN0 = 16 * MiB, WS_WGLU = 20 * MiB, WS_WOUT0 = 21 * MiB, WS_WINC = 23 * MiB, WS_WOUTC = 29 * MiB;
constexpr size_t WS_WGU = 32 * MiB, WS_WD = 96 * MiB, WS_MOE_LAYER = 96 * MiB;
constexpr size_t WS_HB = 224 * MiB;
constexpr size_t WS_PROJ = 256 * MiB, WS_CONCAT = 312 * MiB, WS_YSSM = 344 * MiB;
constexpr size_t WS_BGATE = 256 * MiB, WS_ZC = 288 * MiB, WS_G2 = 320 * MiB;
constexpr size_t WS_H = 364 * MiB, WS_Y = 404 * MiB, WS_END = 494 * MiB;
constexpr size_t WS_UG = 474 * MiB;
constexpr size_t WS_LAM = 404 * MiB  , WS_KF = 406 * MiB  , WS_CT = 408 * MiB  , WS_BEND = 409 * MiB, WS_SEND = 420 * MiB, WS_SIN = 426 * MiB;
constexpr size_t WS_OPART = 432 * MiB, WS_MPART = 470 * MiB, WS_LPART = 472 * MiB;
constexpr size_t WS_DBGA = 364 * MiB, WS_DBGB = 384 * MiB;
constexpr int CW_BAR = 4096;
constexpr int CW_CNT = 16384;
constexpr int CW_DBG = 40960;

constexpr int RING_BYTES = 131072;
constexpr int TAB_OFF = RING_BYTES;
constexpr int TAB_TILE_E = TAB_OFF, TAB_TILE_M = TAB_OFF + 768, TAB_NT = TAB_OFF + 1536, TAB_TOK = TAB_OFF + 2048, TAB_GATE = TAB_OFF + 2048 + 4096;
constexpr int MISC_OFF = TAB_OFF + 2048 + 8192;
constexpr int LDS_BYTES = MISC_OFF + 256;

__device__ __forceinline__ unsigned cvt_pk_bf16(float lo, float hi) { unsigned r; asm volatile("v_cvt_pk_bf16_f32 %0, %1, %2" : "=v"(r) : "v"(lo), "v"(hi)); return r; }
__device__ __forceinline__ float bf_lo(unsigned w) { return __uint_as_float(w << 16); }
__device__ __forceinline__ float bf_hi(unsigned w) { return __uint_as_float(w & 0xffff0000u); }
__device__ __forceinline__ float bf2f(bf16_t b) { return __uint_as_float(((unsigned)b) << 16); }
__device__ __forceinline__ unsigned f2bf(float f) { unsigned u = __float_as_uint(f); return (u + 0x7fffu + ((u >> 16) & 1u)) >> 16; }
__device__ __forceinline__ unsigned pk2(float lo, float hi) { return f2bf(lo) | (f2bf(hi) << 16); }
__device__ __forceinline__ u32x4 pack8(f32x4 a, f32x4 b) { u32x4 w; w.x = cvt_pk_bf16(a[0], a[1]); w.y = cvt_pk_bf16(a[2], a[3]); w.z = cvt_pk_bf16(b[0], b[1]); w.w = cvt_pk_bf16(b[2], b[3]); return w; }
__device__ __forceinline__ void unpack8(u32x4 w, f32x4& a, f32x4& b) { a = (f32x4){bf_lo(w.x), bf_hi(w.x), bf_lo(w.y), bf_hi(w.y)}; b = (f32x4){bf_lo(w.z), bf_hi(w.z), bf_lo(w.w), bf_hi(w.w)}; }
#ifndef WT_STORES
#define WT_STORES 0
#endif
__device__ __forceinline__ void st16(void* p, u32x4 v) {
#if WT_STORES
    asm volatile("global_store_dwordx4 %0, %1, off sc1\n\ts_nop 1" :: "v"(p), "v"(v) : "memory");
#else
    *(u32x4*)p = v;
#endif
}
__device__ __forceinline__ void st16f(void* p, f32x4 v) { st16(p, __builtin_bit_cast(u32x4, v)); }
__device__ __forceinline__ float wave_sum(float v) {
#pragma unroll
    for (int o = 1; o < 64; o <<= 1) v += __shfl_xor(v, o);
    return v;
}
__device__ __forceinline__ float wave_max(float v) {
#pragma unroll
    for (int o = 1; o < 64; o <<= 1) v = fmaxf(v, __shfl_xor(v, o));
    return v;
}
__device__ __forceinline__ float sigmoidf_(float z) { return __builtin_amdgcn_rcpf(1.f + __expf(-z)); }
__device__ __forceinline__ float gelu_tanh(float x) {
    const float z = x * (2.3022082f + 0.10294324f * x * x);
    return x * __builtin_amdgcn_rcpf(1.f + __builtin_amdgcn_exp2f(-z));
}

constexpr int BM = 256, BK = 64, HALF = 128, HTB = HALF * BK * 2, NXCD = 8, WGM = 8;
__host__ __device__ __forceinline__ int lds_byte(int r, int c) { const int st = (r >> 4) * 2 + (c >> 5), rr = r & 15, cc = c & 31, ob = rr * 64 + cc * 2; return st * 1024 + (ob ^ (((ob >> 9) & 1) << 5)); }
__host__ __device__ __forceinline__ void stage_rc(int b, int& R, int& C) { const int st = b / 1024, sb = b % 1024, swz = sb ^ (((sb >> 9) & 1) << 5); R = (st >> 1) * 16 + swz / 64; C = (st & 1) * 32 + (swz % 64) / 2; }
__host__ __device__ __forceinline__ int perm32(int rho) { const int n = rho >> 4, i = rho & 15; return 8 * (i >> 2) + 4 * n + (i & 3); }

struct Unit { int pm, pn, e, half; const char* B; };
__device__ __forceinline__ void unit_map(int L, int nM, int nN, int& pm, int& pn) {
    const int nwg = nM * nN; int wgid = L;
    { const int q = nwg / NXCD, r = nwg % NXCD, xcd = wgid % NXCD, off = wgid / NXCD; wgid = (xcd < r ? xcd * (q + 1) : r * (q + 1) + (xcd - r) * q) + off; }
    const int nig = WGM * nN, gid = wgid / nig, fm = gid * WGM, gsz = (nM - fm) < WGM ? (nM - fm) : WGM;
    pm = fm + ((wgid % nig) % gsz); pn = (wgid % nig) / gsz;
}
struct SchedPlain {
    int nM, nN, G, c, K; const char* Bt;
    __device__ __forceinline__ bool next(int i, Unit& u) const {
        const int L = i * G + c; if (L >= nM * nN) return false;
        unit_map(L, nM, nN, u.pm, u.pn); u.e = 0; u.half = 0; u.B = Bt + (size_t)u.pn * BM * K * 2; return true;
    }
    __device__ __forceinline__ void aoffs(const Unit& u, int, const int (&R)[2], const int (&C)[2], unsigned (&o)[2][2]) const {
#pragma unroll
        for (int h = 0; h < 2; ++h)
#pragma unroll
            for (int i = 0; i < 2; ++i) o[h][i] = (unsigned)(((u.pm * BM + h * HALF + R[i]) * K + C[i]) * 2);
    }
};
struct SchedMoe {
    int ntiles, nN, G, c, K; const char* Bt; size_t strideB; const LAS int* tile_e; const LAS int* tok; const LAS int* tile_m; const LAS int* cntL;
    __device__ __forceinline__ bool next(int i, Unit& u) const {
        const int L = i * G + c; if (L >= ntiles * nN) return false;
        unit_map(L, ntiles, nN, u.pm, u.pn); u.e = tile_e[u.pm]; u.half = (cntL[u.e] - tile_m[u.pm] * 256) <= HALF ? 1 : 0; u.B = Bt + (size_t)u.e * strideB + (size_t)u.pn * BM * K * 2; return true;
    }
    __device__ __forceinline__ void aoffs(const Unit& u, int ui, const int (&R)[2], const int (&C)[2], unsigned (&o)[2][2]) const {
#pragma unroll
        for (int h = 0; h < 2; ++h)
#pragma unroll
            for (int i = 0; i < 2; ++i) {
                const int row = tok ? tok[ui * 256 + h * HALF + R[i]] : (u.pm * BM + h * HALF + R[i]);
                o[h][i] = (unsigned)((row * K + C[i]) * 2);
            }
    }
};

struct SchedSsm {
    int G, c; const char* Bt;
    __device__ __forceinline__ bool next(int i, Unit& u) const {
        const int g = c - (G - NG); if (i != 0 || g < 0) return false;
        u.pm = g; u.pn = 0; u.e = g; u.half = 0; u.B = Bt + (size_t)g * 128 * 1024 * 2; return true;
    }
    __device__ __forceinline__ void aoffs(const Unit& u, int, const int (&R)[2], const int (&C)[2], unsigned (&o)[2][2]) const {
#pragma unroll
        for (int h = 0; h < 2; ++h)
#pragma unroll
            for (int i = 0; i < 2; ++i) o[h][i] = (unsigned)(((u.pm * BM + h * HALF + R[i]) * 1024 + C[i]) * 2);
    }
};
typedef f32x4 Acc[2][2][4][2];

struct EpiProj {
    static constexpr bool PERM = true;
    bf16_t* O; bf16_t* ug; const float* rs; const float* qn; const float* kn;
    __device__ __forceinline__ void operator()(const Acc& acc, const Unit& u, int, int wr, int wc, int fr, int fq) const {
        const int row0 = u.pm * BM + wr * 64 + fr, sigma = u.pn * 4 + wc, col0 = sigma * 64 + 8 * fq;
        const int kind = (sigma >= 10 && sigma < 16) ? 1 : ((sigma >= 16 && sigma < 22) ? 2 : 0);
        f32x4 w[2][2];
#pragma unroll
        for (int bj = 0; bj < 2; ++bj)
#pragma unroll
            for (int n = 0; n < 2; ++n) w[bj][n] = kind ? *(const f32x4*)((kind == 1 ? qn : kn) + 32 * bj + 8 * fq + 4 * n) : (f32x4){1.f, 1.f, 1.f, 1.f};
#pragma unroll
        for (int ai = 0; ai < 2; ++ai)
#pragma unroll
            for (int m = 0; m < 4; ++m) { const int row = row0 + ai * HALF + m * 16; const float s = rs[row];
                f32x4 v[2][2]; float ss = 0.f;
#pragma unroll
                for (int bj = 0; bj < 2; ++bj)
#pragma unroll
                    for (int n = 0; n < 2; ++n) { v[bj][n] = acc[ai][bj][m][n] * s; ss += (v[bj][n][0] * v[bj][n][0] + v[bj][n][1] * v[bj][n][1]) + (v[bj][n][2] * v[bj][n][2] + v[bj][n][3] * v[bj][n][3]); }
                if (kind) { ss += __shfl_xor(ss, 16); ss += __shfl_xor(ss, 32);
                    const float r = rsqrtf(ss * (1.f / HD) + EPS) * (kind == 1 ? 0.125f * 1.4426950408889634f : 1.f);
#pragma unroll
                    for (int bj = 0; bj < 2; ++bj)
#pragma unroll
                        for (int n = 0; n < 2; ++n) v[bj][n] = v[bj][n] * r * w[bj][n]; }
                if (sigma < 10) {
                    bf16_t* up = ug + (((size_t)(4 * sigma + (fq >> 1)) * NB + (row / S)) * S + (row % S)) * GS + 8 * (fq & 1);
#pragma unroll
                    for (int bj = 0; bj < 2; ++bj) st16(up + (size_t)2 * bj * NB * S * GS, pack8(v[bj][0], v[bj][1]));
                } else { bf16_t* rowp = O + (size_t)row * MIXIN + col0;
#pragma unroll
                    for (int bj = 0; bj < 2; ++bj) st16(rowp + 32 * bj, pack8(v[bj][0], v[bj][1])); } }
    }
};
struct EpiSend {
    static constexpr bool PERM = true;
    float* send;
    __device__ __forceinline__ void operator()(const Acc& acc, const Unit& u, int, int wr, int wc, int fr, int fq) const {
#pragma unroll
        for (int ai = 0; ai < 2; ++ai)
#pragma unroll
            for (int m = 0; m < 4; ++m) { const int c = wr * 64 + m * 16 + fr;
                float* o = send + ((size_t)(ai * NG + u.pm) * 128 + c) * 128 + wc * 32 + 8 * fq;
                st16f(o, acc[ai][0][m][0]); st16f(o + 4, acc[ai][0][m][1]); }
    }
};
struct EpiGlu {
    static constexpr bool PERM = true;
    const bf16_t* y; bf16_t* O; const float* bias;
    __device__ __forceinline__ void operator()(const Acc& acc, const Unit& u, int, int wr, int wc, int fr, int fq) const {
        const int row0 = u.pm * BM + wr * 64 + fr, col0 = u.pn * BM + wc * 32 + 8 * fq;
#pragma unroll
        for (int bj = 0; bj < 2; ++bj) {
            const int col = col0 + bj * HALF; if (col >= SSMW) continue;
            const f32x4 b0 = *(const f32x4*)(bias + col), b1 = *(const f32x4*)(bias + col + 4);
#pragma unroll
            for (int ai = 0; ai < 2; ++ai)
#pragma unroll
                for (int m = 0; m < 4; ++m) { const int row = row0 + ai * HALF + m * 16;
                    f32x4 y0, y1; unpack8(*(const u32x4*)(y + (size_t)row * SSMW + col), y0, y1);
                    const f32x4 z0 = acc[ai][bj][m][0] + b0, z1 = acc[ai][bj][m][1] + b1;
                    f32x4 o0, o1;
#pragma unroll
                    for (int j = 0; j < 4; ++j) { o0[j] = y0[j] * sigmoidf_(z0[j]); o1[j] = y1[j] * sigmoidf_(z1[j]); }
                    st16(O + (size_t)row * D + col, pack8(o0, o1)); }
        }
    }
};
struct EpiResid {
    static constexpr bool PERM = true;
    bf16_t* hb;
    __device__ __forceinline__ void operator()(const Acc& acc, const Unit& u, int, int wr, int wc, int fr, int fq) const {
        const int row0 = u.pm * BM + wr * 64 + fr, col0 = u.pn * BM + wc * 32 + 8 * fq;
#pragma unroll
        for (int ai = 0; ai < 2; ++ai)
#pragma unroll
            for (int m = 0; m < 4; ++m) { const size_t off = (size_t)(row0 + ai * HALF + m * 16) * D + col0;
#pragma unroll
                for (int bj = 0; bj < 2; ++bj) { const size_t o = off + bj * HALF;
                    f32x4 r0, r1; unpack8(*(const u32x4*)(hb + o), r0, r1);
                    st16(hb + o, pack8(r0 + acc[ai][bj][m][0], r1 + acc[ai][bj][m][1])); } }
    }
};
struct EpiMoe1 {
    static constexpr bool PERM = true;
    bf16_t* H; const float* rs; const LAS int* tok;
    __device__ __forceinline__ void operator()(const Acc& acc, const Unit& u, int ui, int wr, int wc, int fr, int fq) const {
        const int r0 = wr * 64 + fr, col0 = u.pn * HALF + wc * 32 + 8 * fq;
#pragma unroll
        for (int ai = 0; ai < 2; ++ai)
#pragma unroll
            for (int m = 0; m < 4; ++m) { const int r = r0 + ai * HALF + m * 16; const float s = rs[tok[ui * 256 + r]];
                f32x4 o0, o1;
#pragma unroll
                for (int j = 0; j < 4; ++j) { const float g0 = acc[ai][0][m][0][j] * s, g1 = acc[ai][0][m][1][j] * s;
                    o0[j] = g0 * sigmoidf_(g0) * (acc[ai][1][m][0][j] * s); o1[j] = g1 * sigmoidf_(g1) * (acc[ai][1][m][1][j] * s); }
                st16(H + (size_t)(u.pm * BM + r) * DE + col0, pack8(o0, o1)); }
    }
};
struct EpiMoe2 {
    static constexpr bool PERM = true;
    bf16_t* Y; const LAS float* gate;
    __device__ __forceinline__ void operator()(const Acc& acc, const Unit& u, int ui, int wr, int wc, int fr, int fq) const {
        const int r0 = wr * 64 + fr, col0 = u.pn * BM + wc * 32 + 8 * fq;
#pragma unroll
        for (int ai = 0; ai < 2; ++ai)
#pragma unroll
            for (int m = 0; m < 4; ++m) { const int r = r0 + ai * HALF + m * 16; const float s = gate[ui * 256 + r]; bf16_t* rowp = Y + (size_t)(u.pm * BM + r) * D + col0;
#pragma unroll
                for (int bj = 0; bj < 2; ++bj) st16(rowp + bj * HALF, pack8(acc[ai][bj][m][0] * s, acc[ai][bj][m][1] * s)); }
    }
};
struct EpiConvIn {
    static constexpr bool PERM = true;
    bf16_t* bg; bf16_t* zc; const float* rs;
    __device__ __forceinline__ void operator()(const Acc& acc, const Unit& u, int, int wr, int wc, int fr, int fq) const {
        const int row0 = u.pm * BM + wr * 64 + fr;
#pragma unroll
        for (int ai = 0; ai < 2; ++ai)
#pragma unroll
            for (int m = 0; m < 4; ++m) { const int row = row0 + ai * HALF + m * 16; const float s = rs[row];
                if (u.pn < 4) { bf16_t* rowp = bg + (size_t)row * D + u.pn * BM + wc * 32 + 8 * fq;
#pragma unroll
                    for (int bj = 0; bj < 2; ++bj) st16(rowp + bj * HALF, pack8(acc[ai][bj][m][0] * s, acc[ai][bj][m][1] * s));
                } else { const float s2 = s * s;
                    st16(zc + (size_t)row * D + (u.pn - 4) * HALF + wc * 32 + 8 * fq, pack8(acc[ai][0][m][0] * acc[ai][1][m][0] * s2, acc[ai][0][m][1] * acc[ai][1][m][1] * s2)); } }
    }
};

template <class Epi, class Sched, bool ALIGN_EPI, bool SP2>
__device__ __forceinline__ void gemm_phase(LAS unsigned char* lds, const int tid, const char* Abase, const int K, const Sched& S, const Epi& E) {
    const int wid = __builtin_amdgcn_readfirstlane(tid >> 6), lane = tid & 63, wr = wid >> 2, wc = wid & 3, fr = lane & 15, fq = lane >> 4;
    const int nt = K / BK;
    int Rr[2], Cc[2]; unsigned voffB[2];
#pragma unroll
    for (int i = 0; i < 2; ++i) { int R, C; stage_rc(tid * 16 + i * 8192, R, C); Rr[i] = R; Cc[i] = C; const int Rb = Epi::PERM ? ((R & ~31) + perm32(R & 31)) : R; voffB[i] = (unsigned)(Rb * K + C) * 2u; }
    const size_t kstep = (size_t)(BK * 2);
    const size_t hstep = (size_t)HALF * K * 2;
    const unsigned ldsw = (unsigned)wid * 1024u;
    const int aoff = lds_byte(wr * 64 + fr, fq * 8), boff = lds_byte(wc * 32 + fr, fq * 8);
#define PG8_SA(b, h) (((b) * 2 + (h)) * HTB)
#define PG8_SB(b, h) ((4 + (b) * 2 + (h)) * HTB)
#define PG8_STAGEB(bufoff, gbase) do { _Pragma("unroll") for (int _i = 0; _i < 2; ++_i) \
        __builtin_amdgcn_global_load_lds((const unsigned*)((const char*)(gbase) + voffB[_i]), (LAS unsigned*)(lds + (bufoff) + ldsw + _i * 8192), 16, 0, 0); } while (0)
#define PG8_STAGEA(bufoff, kb, offs, h) do { _Pragma("unroll") for (int _i = 0; _i < 2; ++_i) \
        __builtin_amdgcn_global_load_lds((const unsigned*)(Abase + (size_t)(kb) + (offs)[h][_i]), (LAS unsigned*)(lds + (bufoff) + ldsw + _i * 8192), 16, 0, 0); } while (0)
#define PG8_LDA(dst, b, h) do { _Pragma("unroll") for (int m = 0; m < 4; ++m) _Pragma("unroll") for (int k = 0; k < 2; ++k) dst[m][k] = *(const LAS bf16x8*)(lds + PG8_SA(b, h) + aoff + m * 2048 + k * 1024); } while (0)
#define PG8_LDB(dst, b, h) do { _Pragma("unroll") for (int n = 0; n < 2; ++n) _Pragma("unroll") for (int k = 0; k < 2; ++k) dst[n][k] = *(const LAS bf16x8*)(lds + PG8_SB(b, h) + boff + n * 2048 + k * 1024); } while (0)
#define PG8_MMA(ai, bj, At, Bt) do { __builtin_amdgcn_s_setprio(1); _Pragma("unroll") for (int m = 0; m < 4; ++m) _Pragma("unroll") for (int n = 0; n < 2; ++n) _Pragma("unroll") for (int k = 0; k < 2; ++k) \
        acc[ai][bj][m][n] = __builtin_amdgcn_mfma_f32_16x16x32_bf16(Bt[n][k], At[m][k], acc[ai][bj][m][n], 0, 0, 0); __builtin_amdgcn_s_setprio(0); } while (0)
#define PG8_WAIT_V(n) asm volatile("s_waitcnt vmcnt(" #n ")" ::: "memory")
#define PG8_WAIT_L(n) asm volatile("s_waitcnt lgkmcnt(" #n ")" ::: "memory")
#define PG8_BAR __builtin_amdgcn_s_barrier()
#define PG8_SCHED __builtin_amdgcn_sched_barrier(0)
    Unit cur, nxt; int ui = 0;
    if (!S.next(0, cur)) return;
    Acc acc;
#pragma unroll
    for (int a = 0; a < 2; ++a)
#pragma unroll
        for (int b = 0; b < 2; ++b)
#pragma unroll
            for (int m = 0; m < 4; ++m)
#pragma unroll
                for (int n = 0; n < 2; ++n) acc[a][b][m][n] = (f32x4){0.f, 0.f, 0.f, 0.f};
    bf16x8 At[4][2], B0[2][2], B1[2][2];
    unsigned ca[2][2], na[2][2];
    S.aoffs(cur, 0, Rr, Cc, ca);
    const char* cB = cur.B;
    if constexpr (SP2) {
        PG8_STAGEB(PG8_SB(0, 0), cB); PG8_STAGEB(PG8_SB(0, 1), cB + hstep); PG8_STAGEA(PG8_SA(0, 0), 0, ca, 0); PG8_STAGEA(PG8_SA(0, 1), 0, ca, 1);
        if (wr == 1) PG8_BAR;
        PG8_WAIT_V(2); PG8_BAR;
        PG8_STAGEB(PG8_SB(1, 0), cB + kstep); PG8_STAGEA(PG8_SA(1, 0), kstep, ca, 0); PG8_STAGEB(PG8_SB(1, 1), cB + hstep + kstep);
        PG8_WAIT_V(6); PG8_BAR;
    } else {
        PG8_STAGEB(PG8_SB(0, 0), cB); PG8_STAGEA(PG8_SA(0, 0), 0, ca, 0); PG8_STAGEB(PG8_SB(0, 1), cB + hstep); PG8_STAGEA(PG8_SA(0, 1), 0, ca, 1);
        if (wr == 1) PG8_BAR;
        PG8_WAIT_V(4); PG8_BAR;
        PG8_STAGEB(PG8_SB(1, 0), cB + kstep); PG8_STAGEA(PG8_SA(1, 0), kstep, ca, 0); PG8_STAGEB(PG8_SB(1, 1), cB + hstep + kstep);
        PG8_WAIT_V(6); PG8_BAR;
    }
    for (;;) {
        const bool has_next = S.next(ui + 1, nxt);
        if (has_next) S.aoffs(nxt, ui + 1, Rr, Cc, na);
        else {
#pragma unroll
            for (int h = 0; h < 2; ++h)
#pragma unroll
                for (int i = 0; i < 2; ++i) na[h][i] = ca[h][i];
        }
        const char* nB = has_next ? nxt.B : cB;
        for (int t = 0; t < nt; t += 2) {
            const bool last = (t == nt - 2);
            const size_t k1 = (size_t)(t + 1) * kstep;
            const size_t k2 = last ? 0 : (size_t)(t + 2) * kstep, k3 = k2 + kstep;
            unsigned o2[2][2];
#pragma unroll
            for (int h = 0; h < 2; ++h)
#pragma unroll
                for (int i = 0; i < 2; ++i) o2[h][i] = last ? na[h][i] : ca[h][i];
            const char* b2 = last ? nB : cB + (size_t)(t + 2) * kstep; const char* b3 = b2 + kstep;
            if constexpr (SP2) {
            PG8_LDB(B0, 0, 0); PG8_LDB(B1, 0, 1); PG8_SCHED; PG8_LDA(At, 0, 0); PG8_STAGEA(PG8_SA(1, 1), k1, ca, 1);
            PG8_WAIT_V(8); PG8_WAIT_L(0); PG8_BAR; PG8_MMA(0, 0, At, B0); PG8_MMA(0, 1, At, B1); PG8_BAR; PG8_SCHED;
            PG8_LDA(At, 0, 1); PG8_STAGEB(PG8_SB(0, 0), b2); PG8_STAGEB(PG8_SB(0, 1), b2 + hstep); PG8_STAGEA(PG8_SA(0, 0), k2, o2, 0);
            PG8_WAIT_V(8); PG8_WAIT_L(0); PG8_BAR; if (!cur.half) { PG8_MMA(1, 0, At, B0); PG8_MMA(1, 1, At, B1); } PG8_BAR; PG8_SCHED;
            PG8_LDB(B0, 1, 0); PG8_LDB(B1, 1, 1); PG8_SCHED; PG8_LDA(At, 1, 0); PG8_STAGEA(PG8_SA(0, 1), k2, o2, 1);
            PG8_WAIT_V(8); PG8_WAIT_L(0); PG8_BAR; PG8_MMA(0, 0, At, B0); PG8_MMA(0, 1, At, B1); PG8_BAR; PG8_SCHED;
            PG8_LDA(At, 1, 1); PG8_STAGEB(PG8_SB(1, 0), b3); PG8_STAGEB(PG8_SB(1, 1), b3 + hstep); PG8_STAGEA(PG8_SA(1, 0), k3, o2, 0);
            PG8_WAIT_V(8); PG8_WAIT_L(0); PG8_BAR; if (!cur.half) { PG8_MMA(1, 0, At, B0); PG8_MMA(1, 1, At, B1); } PG8_BAR; PG8_SCHED;
            } else {
            PG8_LDB(B0, 0, 0); PG8_SCHED; PG8_LDA(At, 0, 0); PG8_STAGEA(PG8_SA(1, 1), k1, ca, 1);
            PG8_WAIT_L(8); PG8_BAR; PG8_WAIT_L(0); PG8_MMA(0, 0, At, B0); PG8_BAR; PG8_SCHED;
            PG8_LDB(B1, 0, 1); PG8_STAGEB(PG8_SB(0, 0), b2);
            PG8_BAR; PG8_WAIT_L(0); PG8_MMA(0, 1, At, B1); PG8_BAR;
            PG8_LDA(At, 0, 1); PG8_STAGEA(PG8_SA(0, 0), k2, o2, 0);
            PG8_BAR; PG8_WAIT_L(0); PG8_MMA(1, 0, At, B0); PG8_BAR; PG8_SCHED;
            PG8_STAGEB(PG8_SB(0, 1), b2 + hstep);
            PG8_WAIT_V(6); PG8_BAR; PG8_MMA(1, 1, At, B1); PG8_BAR;
            PG8_LDB(B0, 1, 0); PG8_SCHED; PG8_LDA(At, 1, 0); PG8_STAGEA(PG8_SA(0, 1), k2, o2, 1);
            PG8_WAIT_L(8); PG8_BAR; PG8_WAIT_L(0); PG8_MMA(0, 0, At, B0); PG8_BAR; PG8_SCHED;
            PG8_LDB(B1, 1, 1); PG8_STAGEB(PG8_SB(1, 0), b3);
            PG8_BAR; PG8_WAIT_L(0); PG8_MMA(0, 1, At, B1); PG8_BAR;
            PG8_LDA(At, 1, 1); PG8_STAGEA(PG8_SA(1, 0), k3, o2, 0);
            PG8_BAR; PG8_WAIT_L(0); PG8_MMA(1, 0, At, B0); PG8_BAR; PG8_SCHED;
            PG8_STAGEB(PG8_SB(1, 1), b3 + hstep);
            PG8_WAIT_V(6); PG8_BAR; PG8_MMA(1, 1, At, B1); PG8_BAR;
            }
        }
        if constexpr (ALIGN_EPI) { if (wr == 0) PG8_BAR; }
        E(acc, cur, ui, wr, wc, fr, fq);
        if (!has_next) break;
#pragma unroll
        for (int a = 0; a < 2; ++a)
#pragma unroll
            for (int b = 0; b < 2; ++b)
#pragma unroll
                for (int m = 0; m < 4; ++m)
#pragma unroll
                    for (int n = 0; n < 2; ++n) acc[a][b][m][n] = (f32x4){0.f, 0.f, 0.f, 0.f};
        cur = nxt; cB = nB; ++ui;
#pragma unroll
        for (int h = 0; h < 2; ++h)
#pragma unroll
            for (int i = 0; i < 2; ++i) ca[h][i] = na[h][i];
        if constexpr (ALIGN_EPI) { if (wr == 1) PG8_BAR; }
    }
    PG8_WAIT_V(0);
    if constexpr (!ALIGN_EPI) { if (wr == 0) PG8_BAR; }
    PG8_BAR;
#undef PG8_SA
#undef PG8_SB
#undef PG8_STAGEA
#undef PG8_STAGEB
#undef PG8_LDA
#undef PG8_LDB
#undef PG8_MMA
#undef PG8_WAIT_V
#undef PG8_WAIT_L
#undef PG8_BAR
#undef PG8_SCHED
}

#define XB_TMO      128
#define XB_XCNT(j)  (256  + 64 * (j))
#define XB_XSUB(j)  (1280 + 64 * (j))
#define XB_XGEN(j)  (2304 + 64 * (j))
#define XB_TOP      3328
#define XB_TOPGEN   3392
#define XCD_BAR_WORDS 3456
#define XB_SPIN_CAP (1u << 18)
__device__ __forceinline__ unsigned xb_ld(unsigned* p)              { return __hip_atomic_load(p, __ATOMIC_RELAXED, __HIP_MEMORY_SCOPE_AGENT); }
__device__ __forceinline__ unsigned xb_add(unsigned* p, unsigned v) { return __hip_atomic_fetch_add(p, v, __ATOMIC_RELAXED, __HIP_MEMORY_SCOPE_AGENT); }
__device__ __forceinline__ unsigned xb_xcc_id() { return (unsigned)__builtin_amdgcn_s_getreg((3 << 11) | 20) & 0xFu; }
#define XB_SPIN(cond, bar) do { unsigned _sp = 0; while (cond) { __builtin_amdgcn_s_sleep(1); \
    if ((++_sp & 255u) == 0u) { if (xb_ld(&(bar)[XB_TMO])) break; if (_sp > XB_SPIN_CAP) { atomicAdd(&(bar)[XB_TMO], 1u); break; } } } } while (0)
struct XcdBarrier { unsigned* bar; unsigned x; volatile LAS unsigned* st; };
__device__ __forceinline__ XcdBarrier xcd_barrier_post(unsigned* bar, volatile LAS unsigned* st) {
    XcdBarrier b; b.bar = bar; b.x = xb_xcc_id(); b.st = st;
    if (threadIdx.x == 0) (void)xb_add(&bar[XB_XCNT(b.x)], 1u);
    return b;
}
__device__ __forceinline__ void xcd_barrier_complete(unsigned* bar, unsigned x, unsigned& nloc, unsigned& nx) {
    const unsigned G = gridDim.x * gridDim.y * gridDim.z;
    unsigned sum, cnt, mine, sp = 0u;
    for (;;) {
        sum = 0u; cnt = 0u; mine = 0u;
#pragma unroll
        for (unsigned j = 0; j < 16; ++j) { const unsigned c = xb_ld(&bar[XB_XCNT(j)]); sum += c; cnt += (c > 0u) ? 1u : 0u; mine = (j == x) ? c : mine; }
        if (sum == G) break;
        __builtin_amdgcn_s_sleep(1);
        if ((++sp & 255u) == 0u) { if (xb_ld(&bar[XB_TMO])) break; if (sp > XB_SPIN_CAP) { atomicAdd(&bar[XB_TMO], 1u); break; } }
    }
    nloc = mine > 0u ? mine : 1u; nx = cnt > 0u ? cnt : 1u;
}
__device__ __forceinline__ void xcd_barrier(const XcdBarrier& b) {
    asm volatile("s_waitcnt vmcnt(0)" ::: "memory");
    __syncthreads();
    if (threadIdx.x == 0) {
        unsigned* bar = b.bar;
        __builtin_amdgcn_s_waitcnt(0);
        unsigned nloc = b.st[0], nx = b.st[1];
        if (nloc == 0u) { xcd_barrier_complete(bar, b.x, nloc, nx); b.st[0] = nloc; b.st[1] = nx; }
        const unsigned old = xb_add(&bar[XB_XSUB(b.x)], 1u);
        const unsigned gen = old / nloc;
        if (old + 1u == (gen + 1u) * nloc) {
            __builtin_amdgcn_fence(__ATOMIC_RELEASE, "agent");
            asm volatile("s_waitcnt vmcnt(0)" ::: "memory");
            const unsigned og = xb_add(&bar[XB_TOP], 1u);
            const unsigned tg = og / nx;
            if (og + 1u == (tg + 1u) * nx) xb_add(&bar[XB_TOPGEN], 1u);
            else XB_SPIN(xb_ld(&bar[XB_TOPGEN]) == tg, bar);
            __builtin_amdgcn_fence(__ATOMIC_ACQUIRE, "agent");
            xb_add(&bar[XB_XGEN(b.x)], 1u);
            asm volatile("s_waitcnt vmcnt(0)" ::: "memory");
        } else {
            XB_SPIN(xb_ld(&bar[XB_XGEN(b.x)]) == gen, bar);
            __builtin_amdgcn_fence(__ATOMIC_ACQUIRE, "agent");
            asm volatile("s_waitcnt vmcnt(0)" ::: "memory");
        }
    }
    __syncthreads();
}

struct Args { const float* in[27]; float* out; unsigned char* ws; int ph_lo, ph_hi, dry, pad; };
typedef float f32x16 __attribute__((ext_vector_type(16)));
typedef short s16x4 __attribute__((ext_vector_type(4)));

__device__ __forceinline__ void tr_item(const float* W, int ldn, int K, int k0, int n0, bf16_t* WT, int orow0, const float* gk, LAS float* scr, int lane) {
    float v[32];
    const float* src = W + (size_t)(k0 + (lane >> 5)) * ldn + n0 + (lane & 31);
#pragma unroll
    for (int i = 0; i < 32; ++i) v[i] = src[(size_t)(2 * i) * ldn];
    const int c = lane & 7;
    f32x4 g0 = (f32x4){1.f, 1.f, 1.f, 1.f}, g1 = g0;
    if (gk) { g0 = *(const f32x4*)(gk + k0 + 8 * c); g1 = *(const f32x4*)(gk + k0 + 8 * c + 4); }
#pragma unroll
    for (int i = 0; i < 32; ++i) scr[(2 * i + (lane >> 5)) * 33 + (lane & 31)] = v[i];
    asm volatile("s_waitcnt lgkmcnt(0)" ::: "memory");
#pragma unroll
    for (int j = 0; j < 4; ++j) { const int n = (lane >> 3) + 8 * j; const LAS float* s = scr + (8 * c) * 33 + n;
        u32x4 o; o.x = pk2(s[0 * 33] * g0[0], s[1 * 33] * g0[1]); o.y = pk2(s[2 * 33] * g0[2], s[3 * 33] * g0[3]); o.z = pk2(s[4 * 33] * g1[0], s[5 * 33] * g1[1]); o.w = pk2(s[6 * 33] * g1[2], s[7 * 33] * g1[3]);
        st16(WT + (size_t)(orow0 + n) * K + k0 + 8 * c, o); }
    asm volatile("s_waitcnt lgkmcnt(0)" ::: "memory");
}
__device__ __forceinline__ void conv_matrix(const float* W, int K, int N, bf16_t* WT, const float* gk, int mode, int item, LAS float* scr, int lane) {
    const int nnb = N / 32, kb = item / nnb, nb = item % nnb, k0 = kb * 64, n0 = nb * 32;
    int orow = n0;
    if (mode == 1) orow = 256 * (n0 >> 7) + (n0 & 127);
    else if (mode == 2) orow = 256 * (n0 >> 7) + 128 + (n0 & 127);
    else if (mode == 3) {
        if (n0 >= 2 * D) { const int cc = n0 - 2 * D; orow = 256 * (4 + (cc >> 7)) + 128 + (cc & 127); }
        else if (n0 >= D) { const int cc = n0 - D; orow = 256 * (4 + (cc >> 7)) + (cc & 127); }
    } else if (mode == 4) { const int sg = n0 >> 6; orow = 256 * (sg >> 2) + 128 * ((n0 >> 5) & 1) + 32 * (sg & 3); }
    tr_item(W, N, K, k0, n0, WT, orow, gk, scr, lane);
}
__device__ __forceinline__ void cpow(float lre, float lim, float step, float n, float& wr, float& wi) {
    const float er = expf(n * lre * step), ang = n * lim * step; wr = er * cosf(ang); wi = er * sinf(ang);
}
__device__ __forceinline__ f32x4 mfma16(bf16x8 a, bf16x8 b, f32x4 c) { return __builtin_amdgcn_mfma_f32_16x16x32_bf16(a, b, c, 0, 0, 0); }
__device__ __forceinline__ f32x16 mfma32(bf16x8 a, bf16x8 b, f32x16 c) { return __builtin_amdgcn_mfma_f32_32x32x16_bf16(a, b, c, 0, 0, 0); }
__device__ __forceinline__ s16x4 vtr(LAS unsigned char* p) { return __builtin_bit_cast(s16x4, __builtin_amdgcn_ds_read_tr16_b64_v4i16((LAS s16x4*)p)); }

__global__ void __launch_bounds__(512, 2) fwd(Args args) {
    extern __shared__ __attribute__((aligned(16))) unsigned char lds_raw[];
    LAS unsigned char* lds = (LAS unsigned char*)lds_raw;
    const int G = gridDim.x, bx = blockIdx.x, NGW = G * 8;
    volatile LAS unsigned* MISC = (volatile LAS unsigned*)(lds + MISC_OFF);
    if (threadIdx.x < 64) MISC[threadIdx.x] = 0u;
    __syncthreads();
    XcdBarrier bar; bar.bar = (unsigned*)(args.ws + WS_CTL) + CW_BAR; bar.x = 0; bar.st = nullptr;
    if (NLAUNCH == 1) bar = xcd_barrier_post((unsigned*)(args.ws + WS_CTL) + CW_BAR, MISC);
    const int lo = args.ph_lo, hi = args.ph_hi;
#define IN(k) (lo <= (k) && (k) < hi)
#define SEAM(k) do { if (NLAUNCH == 1 && IN((k) + 1)) xcd_barrier(bar); } while (0)
#define PH_ENTER \
    int tid = threadIdx.x; asm volatile("" : "+v"(tid)); \
    const int lane = tid & 63, wave = __builtin_amdgcn_readfirstlane(tid >> 6), gw = bx * 8 + wave; \
    unsigned char* ws = args.ws; asm volatile("" : "+s"(ws)); \
    float* hout = args.out; asm volatile("" : "+s"(hout)); \
    unsigned* ctl = (unsigned*)(ws + WS_CTL); (void)ctl; (void)lane; (void)gw; \
    float* rs_mix = (float*)(ws + WS_RSMIX); float* rs_ffn = (float*)(ws + WS_RSFFN); (void)rs_mix; (void)rs_ffn; \
    int* tokrow = (int*)(ws + WS_TOKROW); int* list = (int*)(ws + WS_LIST); float* gatel = (float*)(ws + WS_GATEL); (void)tokrow; (void)list; (void)gatel; \
    bf16_t* hb = (bf16_t*)(ws + WS_HB); (void)hb; \
    bf16_t* proj = (bf16_t*)(ws + WS_PROJ); bf16_t* concat = (bf16_t*)(ws + WS_CONCAT); bf16_t* yssm = (bf16_t*)(ws + WS_YSSM); (void)proj; (void)concat; (void)yssm; \
    bf16_t* bgate = (bf16_t*)(ws + WS_BGATE); bf16_t* zcb = (bf16_t*)(ws + WS_ZC); bf16_t* g2b = (bf16_t*)(ws + WS_G2); (void)bgate; (void)zcb; (void)g2b; \
    bf16_t* Hb = (bf16_t*)(ws + WS_H); bf16_t* Yb = (bf16_t*)(ws + WS_Y); (void)Hb; (void)Yb;

    if (IN(PH_PRO)) { PH_ENTER
        const float* x = args.in[0];
        LAS float* scr = (LAS float*)(lds + wave * 16384);
        constexpr int I_IN0 = 16 * 56, I_GLU = 10 * 20, I_O0 = 16 * 32, I_INC = 16 * 96, I_OC = 16 * 32, I_DENSE = I_IN0 + I_GLU + I_O0 + I_INC + I_OC;
        constexpr int I_EXP = 768, NITEMS = I_DENSE + NE * I_EXP;
#define EXPERT_ITEMS(gw_, ngw_, first_, last_) do { for (int it_ = (first_) + (gw_); it_ < (last_); it_ += (ngw_)) { \
            const int le_ = it_ / I_EXP, layer_ = le_ / NE, e_ = le_ % NE, r_ = it_ % I_EXP; \
            bf16_t* wgu_ = (bf16_t*)(ws + WS_WGU + (size_t)layer_ * WS_MOE_LAYER) + (size_t)e_ * D * D; \
            bf16_t* wd_ = (bf16_t*)(ws + WS_WD + (size_t)layer_ * WS_MOE_LAYER) + (size_t)e_ * D * DE; \
            const size_t eoff_ = ((size_t)layer_ * NE + e_) * D * DE; \
            if (r_ < 256) conv_matrix(args.in[24] + eoff_, D, DE, wgu_, args.in[2] + layer_ * D, 1, r_, scr, lane); \
            else if (r_ < 512) conv_matrix(args.in[25] + eoff_, D, DE, wgu_, args.in[2] + layer_ * D, 2, r_ - 256, scr, lane); \
            else conv_matrix(args.in[26] + eoff_, DE, D, wd_, nullptr, 0, r_ - 512, scr, lane); } } while (0)
#define DENSE_ITEMS(gw_, ngw_, first_, last_) do { for (int it_ = (first_) + (gw_); it_ < (last_); it_ += (ngw_)) { int r_ = it_; \
            if (r_ < 896) { conv_matrix(args.in[3], D, MIXIN, (bf16_t*)(ws + WS_WIN0), args.in[1], 4, r_, scr, lane); continue; } r_ -= 896; \
            if (r_ < 200) { conv_matrix(args.in[12], SSMW, SSMW, (bf16_t*)(ws + WS_WGLU), nullptr, 0, r_, scr, lane); continue; } r_ -= 200; \
            if (r_ < 512) { conv_matrix(args.in[16], D, D, (bf16_t*)(ws + WS_WOUT0), nullptr, 0, r_, scr, lane); continue; } r_ -= 512; \
            if (r_ < 1536) { conv_matrix(args.in[17], D, CONVN, (bf16_t*)(ws + WS_WINC), args.in[1] + D, 3, r_, scr, lane); continue; } r_ -= 1536; \
            conv_matrix(args.in[19], D, D, (bf16_t*)(ws + WS_WOUTC), nullptr, 0, r_, scr, lane); } } while (0)
        static_assert(I_IN0 == 896 && I_GLU == 200 && I_O0 == 512 && I_INC == 1536 && I_OC == 512, "dense item list");
        DENSE_ITEMS(gw, NGW, 0, 896);
        (void)NITEMS;
        EXPERT_ITEMS(gw, NGW, 0, NE * I_EXP - FILL_IN - FILL_GLU);
        { u32x4* z = (u32x4*)((bf16_t*)(ws + WS_WGLU) + (size_t)SSMW * SSMW); const int n16 = (GLUN - SSMW) * SSMW * 2 / 16;
          for (int i = bx * 512 + tid; i < n16; i += G * 512) z[i] = (u32x4){0u, 0u, 0u, 0u}; }
        { bf16_t* wrt = (bf16_t*)(ws + WS_WRT);
          for (int i = bx * 512 + tid; i < 2 * 48 * D; i += G * 512) { const int layer = i / (48 * D), n = (i / D) % 48, k = i % D;
              float v = 0.f;
              if (n < 4) v = args.in[20][((size_t)layer * D + k) * 4 + n]; else if (n < 36) v = args.in[22][((size_t)layer * D + k) * NE + (n - 4)];
              v *= args.in[2][layer * D + k];
              const unsigned hi = f2bf(v); const float rem = v - __uint_as_float(hi << 16);
              wrt[(size_t)layer * 2 * 48 * D + (size_t)n * D + k] = (bf16_t)hi; wrt[(size_t)layer * 2 * 48 * D + 48 * D + (size_t)n * D + k] = (bf16_t)f2bf(rem); } }
        {
            const float* a_re = args.in[4]; const float* a_im = args.in[5]; const float* b_re = args.in[6]; const float* b_im = args.in[7];
            const float* c_re = args.in[8]; const float* c_im = args.in[9]; const float* logstep = args.in[11];
            float* Lam = (float*)(ws + WS_LAM); bf16_t* Kf = (bf16_t*)(ws + WS_KF); bf16_t* Ct = (bf16_t*)(ws + WS_CT); bf16_t* Bend = (bf16_t*)(ws + WS_BEND);
            for (int i = bx * 512 + tid; i < NG * 64 * NS; i += G * 512) { const int g = i / (64 * NS), t = (i / NS) % 64, p = i % NS;
                float wr_, wi_; cpow(a_re[g * NS + p], a_im[g * NS + p], expf(logstep[g]), (float)(t + 1), wr_, wi_);
                const int rt = t >> 4, row = t & 15, kc = p >> 4, kq = (p >> 2) & 3, half = (p >> 1) & 1, q = p & 1;
                float* o = Lam + ((((size_t)(g * 4 + rt) * 4 + kc) * 2 + half) * 64 + kq * 16 + row) * 4 + 2 * q; o[0] = wr_; o[1] = wi_; }
            for (int i = bx * 512 + tid; i < NG * NS * 64; i += G * 512) { const int g = i / (NS * 64), p = (i / 64) % NS, j = i % 64;
                const float lre = a_re[g * NS + p], lim = a_im[g * NS + p], step = expf(logstep[g]);
                float l1r, l1i; cpow(lre, lim, step, 1.f, l1r, l1i);
                const float nr = l1r - 1.f, ni = l1i, den = lre * lre + lim * lim, fr_ = (nr * lre + ni * lim) / den, fi_ = (ni * lre - nr * lim) / den;
                float wr_, wi_; cpow(lre, lim, step, (float)(63 - j), wr_, wi_);
                const float gr = wr_ * fr_ - wi_ * fi_, gi = wr_ * fi_ + wi_ * fr_;
                unsigned zr[8], zi[8];
#pragma unroll
                for (int h2 = 0; h2 < 8; ++h2) { float re[2], im[2];
#pragma unroll
                    for (int q = 0; q < 2; ++q) { const float xr = b_re[((size_t)g * NS + p) * GS + 2 * h2 + q], xi = b_im[((size_t)g * NS + p) * GS + 2 * h2 + q]; re[q] = gr * xr - gi * xi; im[q] = gr * xi + gi * xr; }
                    zr[h2] = pk2(re[0], re[1]); zi[h2] = pk2(im[0], im[1]); }
                u32x4* o0 = (u32x4*)(Bend + ((size_t)g * 128 + 2 * p) * 1024 + j * 16); u32x4* o1 = (u32x4*)(Bend + ((size_t)g * 128 + 2 * p + 1) * 1024 + j * 16);
                o0[0] = (u32x4){zr[0], zr[1], zr[2], zr[3]}; o0[1] = (u32x4){zr[4], zr[5], zr[6], zr[7]};
                o1[0] = (u32x4){zi[0], zi[1], zi[2], zi[3]}; o1[1] = (u32x4){zi[4], zi[5], zi[6], zi[7]}; }
            for (int i = bx * 512 + tid; i < NG * GS * NS; i += G * 512) { const int g = i / (GS * NS), h = (i / NS) % GS, p = i % NS;
                const int k = 2 * p, kc = k >> 5, kq = (k >> 3) & 3, j = k & 7;
                *(unsigned*)(Ct + (((size_t)g * 4 + kc) * 64 + kq * 16 + h) * 8 + j) = pk2(c_re[i], -c_im[i]); }
            LAS float* fw = (LAS float*)(lds + 8 * 16384 + wave * 512);
            for (int task = gw; task < NG * 64; task += NGW) { const int g = task / 64, tau = task % 64;
                { const int p = lane; const float lre = a_re[g * NS + p], lim = a_im[g * NS + p], step = expf(logstep[g]);
                  float l1r, l1i; cpow(lre, lim, step, 1.f, l1r, l1i);
                  const float nr = l1r - 1.f, ni = l1i, den = lre * lre + lim * lim, fr_ = (nr * lre + ni * lim) / den, fi_ = (ni * lre - nr * lim) / den;
                  float wr_, wi_; cpow(lre, lim, step, (float)tau, wr_, wi_);
                  fw[2 * p] = wr_ * fr_ - wi_ * fi_; fw[2 * p + 1] = wr_ * fi_ + wi_ * fr_; }
                asm volatile("s_waitcnt lgkmcnt(0)" ::: "memory"); __builtin_amdgcn_wave_barrier();
                const int h = lane >> 2, hq = (lane & 3) * 4; float acc4[4] = {0.f, 0.f, 0.f, 0.f};
                for (int p = 0; p < NS; ++p) { const float fr_ = fw[2 * p], fi_ = fw[2 * p + 1];
                    const float cr = c_re[((size_t)g * GS + h) * NS + p], ci = c_im[((size_t)g * GS + h) * NS + p];
                    const float er = cr * fr_ - ci * fi_, ei = cr * fi_ + ci * fr_;
                    const f32x4 xr = *(const f32x4*)(b_re + ((size_t)g * NS + p) * GS + hq), xi = *(const f32x4*)(b_im + ((size_t)g * NS + p) * GS + hq);
#pragma unroll
                    for (int q = 0; q < 4; ++q) acc4[q] += er * xr[q] - ei * xi[q]; }
                { const int ks = tau >> 1, kq2 = 2 * (tau & 1) + (hq >> 3), j = hq & 7;
                  *(u32x2*)(Kf + (((size_t)g * 32 + ks) * 64 + kq2 * 16 + h) * 8 + j) = (u32x2){pk2(acc4[0], acc4[1]), pk2(acc4[2], acc4[3])}; }
                asm volatile("s_waitcnt lgkmcnt(0)" ::: "memory"); __builtin_amdgcn_wave_barrier();
            }
        }
        for (int m = gw; m < T; m += NGW) {
            const f32x4* xr = (const f32x4*)(x + (size_t)m * D) + lane; f32x4 v[4]; float s = 0.f;
#pragma unroll
            for (int j = 0; j < 4; ++j) { v[j] = xr[64 * j]; s += (v[j].x * v[j].x + v[j].y * v[j].y) + (v[j].z * v[j].z + v[j].w * v[j].w); }
            s = wave_sum(s);
            if (lane == 0) rs_mix[m] = rsqrtf(s * (1.f / D) + EPS);
            u32x2* o8 = (u32x2*)(hb + (size_t)m * D) + lane;
#pragma unroll
            for (int j = 0; j < 4; ++j) o8[64 * j] = (u32x2){cvt_pk_bf16(v[j].x, v[j].y), cvt_pk_bf16(v[j].z, v[j].w)};
        }
        SEAM(PH_PRO);
    }

    if (IN(PH_INPROJ)) { PH_ENTER
        SchedPlain Sd{T / BM, MIXIN / BM, G, bx, D, (const char*)(ws + WS_WIN0)};
        EpiProj E{proj, (bf16_t*)(ws + WS_UG), rs_mix, args.in[14], args.in[15]};
        gemm_phase<EpiProj, SchedPlain, true, true>(lds, tid, (const char*)hb, D, Sd, E);
        { constexpr int I_EXP = 768; LAS float* scr = (LAS float*)(lds + wave * 16384); const int r = ((T / BM) * (MIXIN / BM)) % G;
          __syncthreads();
          if (r == 0) { DENSE_ITEMS(gw, NGW, 896, 1096); EXPERT_ITEMS(gw, NGW, NE * I_EXP - FILL_IN - FILL_GLU, NE * I_EXP - FILL_GLU); }
          else if (bx >= r) { DENSE_ITEMS((bx - r) * 8 + wave, (G - r) * 8, 896, 1096); EXPERT_ITEMS((bx - r) * 8 + wave, (G - r) * 8, NE * I_EXP - FILL_IN - FILL_GLU, NE * I_EXP - FILL_GLU); } }
        SEAM(PH_INPROJ);
    }

    if (IN(PH_ATTN)) { PH_ENTER
        const bool split_sa = G >= 4 * NG;
        if (!DRY_MASK || args.dry != 3) {
            SchedSsm Sd{split_sa ? G : NG, bx, (const char*)(ws + WS_BEND)};
            EpiSend E{(float*)(ws + WS_SEND)};
            gemm_phase<EpiSend, SchedSsm, true, true>(lds, tid, (const char*)(ws + WS_UG), 1024, Sd, E);
        }
        if (!DRY_MASK || args.dry != 2) {
            bf16_t* opart = (bf16_t*)(ws + WS_OPART); float* mpart = (float*)(ws + WS_MPART); float* lpart = (float*)(ws + WS_LPART);
            constexpr int KST = 144, VST = 192, VOFF = 384 * KST;
            const int r32 = lane & 31, hh = lane >> 5;
            u32x4 pk[6], pv[6];
#define ATT_DECODE(unit_) const int pat = (unit_) / 384, rem = (unit_) % 384, bh = rem % 12, b = bh / AH, h = bh % AH, rq = rem / 12; \
                const int dil = pat == 0 ? 1 : (pat == 1 ? 4 : 16), nqb = 32 / dil, res = rq / nqb, qb = rq % nqb; \
                const bf16_t* base = proj + (size_t)(b * S + res) * MIXIN + h * HD; const size_t tstride = (size_t)dil * MIXIN; const int i0 = 256 * qb - 128;
#define ATT_LOAD(unit_) do { ATT_DECODE(unit_) (void)h; \
                _Pragma("unroll") for (int j = 0; j < 6; ++j) { const int ch = tid + 512 * j, rho = ch >> 3, c16 = ch & 7, i = i0 + rho; const bf16_t* rp = base + (size_t)(i < 0 ? 0 : i) * tstride + SSMW + AW + c16 * 8; \
                    pk[j] = *(const u32x4*)rp; pv[j] = *(const u32x4*)(rp + AW); } } while (0)
            const int GA = split_sa ? G - NG : G, NU5 = (split_sa && 5 * GA < 3 * 384) ? 5 * GA : 3 * 384;
            const int u_first = bx < GA ? bx : NU5 + (bx - GA), u_step = bx < GA ? GA : NG, u_end = bx < GA ? NU5 : 3 * 384;
            if (u_first < u_end) ATT_LOAD(u_first);
            for (int unit = u_first; unit < u_end; unit += u_step) {
                ATT_DECODE(unit)
                __syncthreads();
                { int tl = tid; asm volatile("" : "+v"(tl));
#pragma unroll
                for (int j = 0; j < 6; ++j) { const int ch = tl + 512 * j, rho = ch >> 3, c16 = ch & 7;
                    *(LAS u32x4*)(lds + rho * KST + c16 * 16) = pk[j]; *(LAS u32x4*)(lds + VOFF + rho * VST + c16 * 16) = pv[j]; } }
                __syncthreads();
                const float slope2 = exp2f(-8.0f * (h + 1) / AH) * (float)dil * 1.4426950408889634f;
                const int iq = 256 * qb + 32 * wave + r32;
                bf16x8 qf[4];
#pragma unroll
                for (int s = 0; s < 4; ++s) qf[s] = *(const bf16x8*)(base + (size_t)iq * tstride + SSMW + 16 * s + 8 * hh);
                f32x16 sc[5];
                const LAS unsigned char* kb = lds + (32 * wave + r32) * KST + hh * 16;
#pragma unroll
                for (int kt = 0; kt < 5; ++kt) {
                    f32x16 a = (f32x16){0.f, 0.f, 0.f, 0.f, 0.f, 0.f, 0.f, 0.f, 0.f, 0.f, 0.f, 0.f, 0.f, 0.f, 0.f, 0.f};
#pragma unroll
                    for (int s = 0; s < 4; ++s) a = mfma32(*(const LAS bf16x8*)(kb + kt * 32 * KST + s * 32), qf[s], a);
                    sc[kt] = a;
                }
                if (unit + u_step < u_end) ATT_LOAD(unit + u_step);
                float loff = (float)(r32 - 4 * hh); asm volatile("" : "+v"(loff));
                const float dhalf = 0.5f * (float)(iq < 128 ? iq : 128);
                float mx = -INFINITY;
#pragma unroll
                for (int kt = 0; kt < 5; ++kt)
#pragma unroll
                    for (int r = 0; r < 16; ++r) { const float diff = loff + (float)(128 - 32 * kt - ((r & 3) + 8 * (r >> 2)));
                        float v = sc[kt][r] - slope2 * diff;
                        if (kt == 0 || kt == 4 || qb == 0) v = (fabsf(diff - dhalf) <= dhalf) ? v : -INFINITY;
                        sc[kt][r] = v; mx = fmaxf(mx, v); }
                mx = fmaxf(mx, __shfl_xor(mx, 32));
                float l = 0.f;
#pragma unroll
                for (int kt = 0; kt < 5; ++kt)
#pragma unroll
                    for (int r = 0; r < 16; ++r) { const float e = __builtin_amdgcn_exp2f(sc[kt][r] - mx); sc[kt][r] = e; l += e; }
                l += __shfl_xor(l, 32);
                f32x16 o[2];
#pragma unroll
                for (int dt = 0; dt < 2; ++dt) o[dt] = (f32x16){0.f, 0.f, 0.f, 0.f, 0.f, 0.f, 0.f, 0.f, 0.f, 0.f, 0.f, 0.f, 0.f, 0.f, 0.f, 0.f};
                const int G4 = lane >> 4, q4 = (lane & 15) >> 2, p4 = lane & 3;
                LAS unsigned char* vb = lds + VOFF + (32 * wave + 4 * (G4 >> 1) + q4) * VST + (16 * (G4 & 1) + 4 * p4) * 2;
#pragma unroll
                for (int kt = 0; kt < 5; ++kt)
#pragma unroll
                    for (int s2 = 0; s2 < 2; ++s2) {
                        const bf16x8 pfv = __builtin_bit_cast(bf16x8, (u32x4){cvt_pk_bf16(sc[kt][8 * s2 + 0], sc[kt][8 * s2 + 1]), cvt_pk_bf16(sc[kt][8 * s2 + 2], sc[kt][8 * s2 + 3]),
                                                                               cvt_pk_bf16(sc[kt][8 * s2 + 4], sc[kt][8 * s2 + 5]), cvt_pk_bf16(sc[kt][8 * s2 + 6], sc[kt][8 * s2 + 7])});
#pragma unroll
                        for (int dt = 0; dt < 2; ++dt) {
                            const s16x4 lo4 = vtr(vb + (kt * 32 + s2 * 16) * VST + dt * 64), hi4 = vtr(vb + (kt * 32 + s2 * 16 + 8) * VST + dt * 64);
                            const bf16x8 vf = (bf16x8){lo4[0], lo4[1], lo4[2], lo4[3], hi4[0], hi4[1], hi4[2], hi4[3]};
                            o[dt] = mfma32(vf, pfv, o[dt]); }
                    }
                const float rl = 1.f / l;
                const size_t tok = (size_t)(b * S + res) + (size_t)iq * dil;
                bf16_t* op = opart + ((size_t)pat * T + tok) * AW + h * HD;
#pragma unroll
                for (int dt = 0; dt < 2; ++dt)
#pragma unroll
                    for (int r4 = 0; r4 < 4; ++r4) *(u32x2*)(op + 32 * dt + 8 * r4 + 4 * hh) = (u32x2){cvt_pk_bf16(o[dt][4 * r4] * rl, o[dt][4 * r4 + 1] * rl), cvt_pk_bf16(o[dt][4 * r4 + 2] * rl, o[dt][4 * r4 + 3] * rl)};
                if (hh == 0) { mpart[((size_t)pat * T + tok) * AH + h] = mx; lpart[((size_t)pat * T + tok) * AH + h] = l; }
            }
            __syncthreads();
#undef ATT_DECODE
#undef ATT_LOAD
        }
#if DBG == 2
        {
            bf16_t* dbg = (bf16_t*)(ws + WS_DBGA);
            LAS float* scn = (LAS float*)(lds + 65536 + wave * 2048);
            for (int gi = gw; gi < T * AH; gi += NGW) {
                const int tg = gi / AH, h = gi % AH, b = tg / S, t = tg % S;
                const float slope = exp2f(-8.0f * (h + 1) / AH);
                const float q = bf2f(proj[(size_t)tg * MIXIN + SSMW + h * HD + lane]);
                const bf16_t* Kb = proj + (size_t)b * S * MIXIN + SSMW + AW + h * HD;
                const bf16_t* Vb = proj + (size_t)b * S * MIXIN + SSMW + 2 * AW + h * HD;
                for (int idx = 0; idx < 387; ++idx) { const int pp = idx / 129, j = idx % 129, dil = pp == 0 ? 1 : (pp == 1 ? 4 : 16), tk = t - j * dil;
                    float s = -INFINITY;
                    if (tk >= 0) s = wave_sum(q * bf2f(Kb[(size_t)tk * MIXIN + lane])) - slope * 1.4426950408889634f * (float)(j * dil);
                    if (lane == 0) scn[idx] = s; }
                asm volatile("s_waitcnt lgkmcnt(0)" ::: "memory"); __builtin_amdgcn_wave_barrier();
                float m = -INFINITY;
                for (int idx = lane; idx < 387; idx += 64) m = fmaxf(m, scn[idx]);
                m = wave_max(m);
                float l = 0.f;
                for (int idx = lane; idx < 387; idx += 64) { const float s = scn[idx]; const float e = (s == -INFINITY) ? 0.f : exp2f(s - m); scn[idx] = e; l += e; }
                l = wave_sum(l);
                asm volatile("s_waitcnt lgkmcnt(0)" ::: "memory"); __builtin_amdgcn_wave_barrier();
                float o = 0.f;
                for (int idx = 0; idx < 387; ++idx) { const int pp = idx / 129, j = idx % 129, dil = pp == 0 ? 1 : (pp == 1 ? 4 : 16), tk = t - j * dil;
                    if (tk >= 0) o += scn[idx] * bf2f(Vb[(size_t)tk * MIXIN + lane]); }
                dbg[(size_t)tg * AW + h * HD + lane] = (bf16_t)f2bf(o / l);
                asm volatile("s_waitcnt lgkmcnt(0)" ::: "memory"); __builtin_amdgcn_wave_barrier();
            }
        }
#endif
        SEAM(PH_ATTN);
    }


    if (IN(PH_SSMY)) { PH_ENTER
        const bf16_t* Kf = (const bf16_t*)(ws + WS_KF); const bf16_t* Ct = (const bf16_t*)(ws + WS_CT); const float* Lam = (const float*)(ws + WS_LAM);
        const float* send = (const float*)(ws + WS_SEND); const float* dsk = args.in[10];
        const int row = lane & 15, kq = lane >> 4;
        LAS float* sinL = (LAS float*)(lds + 102400);
        float csr = 0.f, csi = 0.f, cwr = 0.f, cwi = 0.f; int sc_gb = -1, sc_c = 0;
        LAS unsigned char* Uw = lds + 69632 + wave * 4096;
        *(LAS u32x4*)(Uw + lane * 32) = (u32x4){0u, 0u, 0u, 0u}; *(LAS u32x4*)(Uw + lane * 32 + 16) = (u32x4){0u, 0u, 0u, 0u};
        int gcur = -1;
        const int NU = NB * NG * 16, per = (NU + G - 1) / G;
        const int u_end = (bx + 1) * per < NU ? (bx + 1) * per : NU;
        u32x4 nv0, nv1;
#define SSM_LOAD(u_) do { const int g_ = (u_) / 32, b_ = ((u_) >> 4) & 1, c_ = ((u_) & 15) * 8 + wave; \
            const bf16_t* up_ = (const bf16_t*)(ws + WS_UG) + ((size_t)(g_ * NB + b_) * S + c_ * 64) * GS + lane * 8; nv0 = *(const u32x4*)up_; nv1 = *(const u32x4*)(up_ + 512); } while (0)
        if (bx * per < u_end) SSM_LOAD(bx * per);
        for (int u = bx * per; u < u_end; ++u) { const int g = u / 32, b = (u >> 4) & 1, cb = u & 15;
            if (g != gcur) { gcur = g; __syncthreads();
                const u32x4* s0 = (const u32x4*)(Kf + (size_t)g * 32 * 64 * 8); const u32x4* s1 = (const u32x4*)(Ct + (size_t)g * 4 * 64 * 8); const u32x4* s2 = (const u32x4*)(Lam + (size_t)g * 4 * 4 * 2 * 64 * 4);
                for (int i = tid; i < 2048; i += 512) *(LAS u32x4*)(lds + i * 16) = s0[i];
                if (tid < 256) *(LAS u32x4*)(lds + 32768 + tid * 16) = s1[tid];
                for (int i = tid; i < 2048; i += 512) *(LAS u32x4*)(lds + 36864 + i * 16) = s2[i];
                __syncthreads(); }
            const int c = cb * 8 + wave, t0 = b * S + c * 64;
            *(LAS u32x4*)(Uw + 2048 + lane * 16) = nv0; *(LAS u32x4*)(Uw + 2048 + 1024 + lane * 16) = nv1;
            if (u + 1 < u_end) SSM_LOAD(u + 1);
            LAS float* sL = sinL + ((u & 1) ? 1024 : 0);
            if (wave == 0) {
                if (g * NB + b != sc_gb) { sc_gb = g * NB + b; sc_c = 0; csr = 0.f; csi = 0.f; cpow(args.in[4][g * NS + lane], args.in[5][g * NS + lane], expf(args.in[11][g]), 64.f, cwr, cwi); }
                const float* sp = send + ((size_t)(b * NG + g) * 128) * 128 + 2 * lane;
                for (; sc_c < 8 * cb; sc_c += 8) { float2 e[8];
#pragma unroll
                    for (int j = 0; j < 8; ++j) e[j] = *(const float2*)(sp + (size_t)(sc_c + j) * 128);
#pragma unroll
                    for (int j = 0; j < 8; ++j) { const float nr = cwr * csr - cwi * csi + e[j].x, ni = cwr * csi + cwi * csr + e[j].y; csr = nr; csi = ni; } }
                { float2 e[8];
#pragma unroll
                  for (int j = 0; j < 8; ++j) e[j] = *(const float2*)(sp + (size_t)(8 * cb + j) * 128);
#pragma unroll
                  for (int j = 0; j < 8; ++j) { sL[j * 128 + 2 * lane] = csr; sL[j * 128 + 2 * lane + 1] = csi;
                      const float nr = cwr * csr - cwi * csi + e[j].x, ni = cwr * csi + cwi * csr + e[j].y; csr = nr; csi = ni; }
                  sc_c = 8 * cb + 8; }
            }
            __syncthreads();
            f32x4 sv[4][2];
#pragma unroll
            for (int kc = 0; kc < 4; ++kc) { sv[kc][0] = *(const LAS f32x4*)(sL + wave * 128 + 32 * kc + 8 * kq); sv[kc][1] = *(const LAS f32x4*)(sL + wave * 128 + 32 * kc + 8 * kq + 4); }
            asm volatile("s_waitcnt lgkmcnt(0)" ::: "memory"); __builtin_amdgcn_wave_barrier();
            f32x4 acc[4];
#pragma unroll
            for (int rt = 0; rt < 4; ++rt) acc[rt] = (f32x4){0.f, 0.f, 0.f, 0.f};
            const LAS unsigned char* ua = Uw + (64 + row - (kq >> 1)) * 32 + (kq & 1) * 16;
#pragma unroll
            for (int kb = 0; kb < 4; ++kb)
#pragma unroll
                for (int k8 = 0; k8 < 8; ++k8) { const int ks = 8 * kb + k8;
                    const bf16x8 bfr = *(const LAS bf16x8*)(lds + (ks * 64 + lane) * 16);
#pragma unroll
                    for (int rt = kb; rt < 4; ++rt) acc[rt] = mfma16(*(const LAS bf16x8*)(ua + (16 * rt - 2 * ks) * 32), bfr, acc[rt]); }
#pragma unroll
            for (int kc = 0; kc < 4; ++kc) { const bf16x8 bfr = *(const LAS bf16x8*)(lds + 32768 + (kc * 64 + lane) * 16);
#pragma unroll
                for (int rt = 0; rt < 4; ++rt) { const LAS unsigned char* lp = lds + 36864 + ((rt * 4 + kc) * 2 * 64 + lane) * 16;
                    const f32x4 l01 = *(const LAS f32x4*)lp, l23 = *(const LAS f32x4*)(lp + 1024); const f32x4 s01 = sv[kc][0], s23 = sv[kc][1];
                    const bf16x8 afv = __builtin_bit_cast(bf16x8, (u32x4){
                        cvt_pk_bf16(l01[0] * s01[0] - l01[1] * s01[1], l01[0] * s01[1] + l01[1] * s01[0]), cvt_pk_bf16(l01[2] * s01[2] - l01[3] * s01[3], l01[2] * s01[3] + l01[3] * s01[2]),
                        cvt_pk_bf16(l23[0] * s23[0] - l23[1] * s23[1], l23[0] * s23[1] + l23[1] * s23[0]), cvt_pk_bf16(l23[2] * s23[2] - l23[3] * s23[3], l23[2] * s23[3] + l23[3] * s23[2])});
                    acc[rt] = mfma16(afv, bfr, acc[rt]); } }
            const float dk = dsk[g * GS + row];
#pragma unroll
            for (int rt = 0; rt < 4; ++rt)
#pragma unroll
                for (int r = 0; r < 4; ++r) { const int tl = 16 * rt + 4 * kq + r, t = t0 + tl;
                    const float uu = bf2f(*(const LAS bf16_t*)(Uw + 2048 + tl * 32 + row * 2));
#if DBG == 1
                    ((bf16_t*)(ws + WS_DBGA))[(size_t)t * SSMW + g * GS + row] = (bf16_t)f2bf(acc[rt][r] * 64.f);
#endif
                    yssm[(size_t)t * SSMW + g * GS + row] = (bf16_t)f2bf(gelu_tanh(acc[rt][r] + dk * uu)); }
            asm volatile("s_waitcnt lgkmcnt(0)" ::: "memory"); __builtin_amdgcn_wave_barrier();
        }
        {
            const bf16_t* opart = (const bf16_t*)(ws + WS_OPART); const float* mpart = (const float*)(ws + WS_MPART); const float* lpart = (const float*)(ws + WS_LPART);
            for (int i = bx * 512 + tid; i < T * AH * 8; i += G * 512) { const int th = i >> 3, c8 = (i & 7) * 8, t = th / AH, h = th % AH;
                float m[3], l[3]; u32x4 o[3];
#pragma unroll
                for (int pp = 0; pp < 3; ++pp) { m[pp] = mpart[((size_t)pp * T + t) * AH + h]; l[pp] = lpart[((size_t)pp * T + t) * AH + h]; o[pp] = *(const u32x4*)(opart + ((size_t)pp * T + t) * AW + h * HD + c8); }
                const float M = fmaxf(m[0], fmaxf(m[1], m[2]));
                float w0 = l[0] * exp2f(m[0] - M), w1 = l[1] * exp2f(m[1] - M), w2 = l[2] * exp2f(m[2] - M);
                const float rw = 1.f / (w0 + w1 + w2); w0 *= rw; w1 *= rw; w2 *= rw;
                f32x4 a0, a1, b0, b1, c0, c1; unpack8(o[0], a0, a1); unpack8(o[1], b0, b1); unpack8(o[2], c0, c1);
                *(u32x4*)(concat + (size_t)t * D + SSMW + h * HD + c8) = pack8(a0 * w0 + b0 * w1 + c0 * w2, a1 * w0 + b1 * w1 + c1 * w2);
            }
        }
        { constexpr int I_EXP = 768; LAS float* scr = (LAS float*)(lds + wave * 16384);
          __syncthreads();
          EXPERT_ITEMS(gw, NGW, NE * I_EXP + FILL_G1 + FILL_G2, 2 * NE * I_EXP); }
#if DBG == 1
        if (wave == 0 && bx < NB * NG) {
            const int b = bx / NG, g = bx % NG, p = lane;
            const float* a_re = args.in[4]; const float* a_im = args.in[5]; const float* b_re = args.in[6]; const float* b_im = args.in[7];
            const float* c_re = args.in[8]; const float* c_im = args.in[9]; const float* logstep = args.in[11];
            const float lre = a_re[g * NS + p], lim = a_im[g * NS + p], step = expf(logstep[g]);
            const float er = expf(lre * step), lbr = er * cosf(lim * step), lbi = er * sinf(lim * step);
            const float nr = lbr - 1.f, ni = lbi, den = lre * lre + lim * lim;
            const float fr_ = (nr * lre + ni * lim) / den, fi_ = (ni * lre - nr * lim) / den;
            float bbr[GS], bbi[GS], cr[GS], ci[GS];
#pragma unroll
            for (int h = 0; h < GS; ++h) {
                const float xr = b_re[((size_t)g * NS + p) * GS + h], xi = b_im[((size_t)g * NS + p) * GS + h];
                bbr[h] = fr_ * xr - fi_ * xi; bbi[h] = fr_ * xi + fi_ * xr;
                cr[h] = c_re[((size_t)g * GS + h) * NS + p]; ci[h] = c_im[((size_t)g * GS + h) * NS + p];
            }
            float sr = 0.f, si = 0.f;
            for (int t = 0; t < S; ++t) {
                const u32x4* up = (const u32x4*)((const bf16_t*)(ws + WS_UG) + ((size_t)(g * NB + b) * S + t) * GS);
                f32x4 u0, u1, u2, u3; unpack8(up[0], u0, u1); unpack8(up[1], u2, u3);
                const float u[GS] = {u0[0], u0[1], u0[2], u0[3], u1[0], u1[1], u1[2], u1[3], u2[0], u2[1], u2[2], u2[3], u3[0], u3[1], u3[2], u3[3]};
                float br = 0.f, bi = 0.f;
#pragma unroll
                for (int h = 0; h < GS; ++h) { br += bbr[h] * u[h]; bi += bbi[h] * u[h]; }
                const float nsr = lbr * sr - lbi * si + br, nsi = lbr * si + lbi * sr + bi;
                sr = nsr; si = nsi;
                float mine = 0.f;
#pragma unroll
                for (int h = 0; h < GS; ++h) { const float v = wave_sum(cr[h] * sr - ci[h] * si); if (p == h) mine = v; }
                if (p < GS) ((bf16_t*)(ws + WS_DBGB))[(size_t)(b * S + t) * SSMW + g * GS + p] = (bf16_t)f2bf(mine * 64.f);
            }
        }
#endif
        SEAM(PH_SSMY);
    }

    if (IN(PH_GLU)) { PH_ENTER
#if DBG
        {
            const bf16_t* A = (const bf16_t*)(ws + WS_DBGA); const bf16_t* B = (const bf16_t*)(ws + WS_DBGB);
            float* acc = (float*)(ctl + CW_DBG);
            const size_t n = (DBG == 1) ? (size_t)T * SSMW : (size_t)T * AW;
            float num = 0.f, den = 0.f;
            if (DBG == 1) { for (size_t i = (size_t)bx * 512 + tid; i < n; i += (size_t)G * 512) { const float a = bf2f(A[i]), b = bf2f(B[i]); num += (a - b) * (a - b); den += b * b; } }
            else { for (size_t i = (size_t)bx * 512 + tid; i < n; i += (size_t)G * 512) { const size_t t = i / AW, c = i % AW; const float a = bf2f(A[i]), b = bf2f(concat[t * D + SSMW + c]); num += (a - b) * (a - b); den += a * a; } }
            num = wave_sum(num); den = wave_sum(den);
            if (lane == 0) { atomicAdd(acc, num); atomicAdd(acc + 1, den); }
        }
#endif
        SchedPlain Sd{T / BM, GLUN / BM, G, bx, SSMW, (const char*)(ws + WS_WGLU)};
        EpiGlu E{yssm, concat, args.in[13]};
        gemm_phase<EpiGlu, SchedPlain, true, true>(lds, tid, (const char*)yssm, SSMW, Sd, E);
        { constexpr int I_EXP = 768; LAS float* scr = (LAS float*)(lds + wave * 16384); const int nu = (T / BM) * (GLUN / BM);
          __syncthreads();
          if (nu >= G) { DENSE_ITEMS(gw, NGW, 1096, 1608); EXPERT_ITEMS(gw, NGW, NE * I_EXP - FILL_GLU, NE * I_EXP); }
          else if (bx >= nu) { DENSE_ITEMS((bx - nu) * 8 + wave, (G - nu) * 8, 1096, 1608); EXPERT_ITEMS((bx - nu) * 8 + wave, (G - nu) * 8, NE * I_EXP - FILL_GLU, NE * I_EXP); } }
        SEAM(PH_GLU);
    }

    if (IN(PH_OUT0)) { PH_ENTER
        SchedPlain Sd{T / BM, D / BM, G, bx, D, (const char*)(ws + WS_WOUT0)};
        EpiResid E{hb};
        gemm_phase<EpiResid, SchedPlain, true, true>(lds, tid, (const char*)concat, D, Sd, E);
        SEAM(PH_OUT0);
    }

    for (int layer = 0; layer < 2; ++layer) {
        const int pb = (layer == 0) ? PH_RT0 : PH_RT1;
        if (IN(pb)) { PH_ENTER
            int* cnt = (int*)(ctl + CW_CNT) + layer * 4096;
#if DRY_MASK
            if (args.dry) { cnt += 8192; list = (int*)(ws + 256 * MiB); gatel = (float*)(ws + 260 * MiB); tokrow = (int*)(ws + 264 * MiB); rs_ffn = (float*)(ws + 266 * MiB); }
#endif
            const float* brg = args.in[21] + layer * 4; const float* bre = args.in[23] + layer * NE;
            const bf16_t* wrt = (const bf16_t*)(ws + WS_WRT) + (size_t)layer * 2 * 48 * D;
            LAS float* L = (LAS float*)(lds + wave * 12544);
            const int row = lane & 15, kq = lane >> 4;
            for (int task = bx; task < T / 64; task += G) {
                const int t0 = task * 64;
                const bf16_t* bp = wrt + (size_t)row * D + 128 * wave + 8 * kq;
                bf16x8 bh[3][4], bl[3][4];
#pragma unroll
                for (int nt = 0; nt < 3; ++nt)
#pragma unroll
                    for (int ks = 0; ks < 4; ++ks) { bh[nt][ks] = *(const bf16x8*)(bp + (size_t)nt * 16 * D + 32 * ks); bl[nt][ks] = *(const bf16x8*)(bp + (size_t)(48 + nt * 16) * D + 32 * ks); }
#pragma unroll
                for (int rt = 0; rt < 4; ++rt) {
                    const bf16_t* ap = hb + (size_t)(t0 + 16 * rt + row) * D + 128 * wave + 8 * kq;
                    u32x4 a[4];
#pragma unroll
                    for (int ks = 0; ks < 4; ++ks) a[ks] = *(const u32x4*)(ap + 32 * ks);
                    f32x4 acc[3] = {(f32x4){0.f, 0.f, 0.f, 0.f}, (f32x4){0.f, 0.f, 0.f, 0.f}, (f32x4){0.f, 0.f, 0.f, 0.f}};
                    float ss = 0.f;
#pragma unroll
                    for (int ks = 0; ks < 4; ++ks) { f32x4 x0, x1; unpack8(a[ks], x0, x1);
                        ss += ((x0[0] * x0[0] + x0[1] * x0[1]) + (x0[2] * x0[2] + x0[3] * x0[3])) + ((x1[0] * x1[0] + x1[1] * x1[1]) + (x1[2] * x1[2] + x1[3] * x1[3]));
                        const bf16x8 af = __builtin_bit_cast(bf16x8, a[ks]);
#pragma unroll
                        for (int nt = 0; nt < 3; ++nt) { acc[nt] = mfma16(af, bh[nt][ks], acc[nt]); acc[nt] = mfma16(af, bl[nt][ks], acc[nt]); } }
                    ss += __shfl_xor(ss, 16); ss += __shfl_xor(ss, 32);
#pragma unroll
                    for (int nt = 0; nt < 3; ++nt)
#pragma unroll
                        for (int r = 0; r < 4; ++r) L[(16 * rt + 4 * kq + r) * 48 + nt * 16 + row] = acc[nt][r];
                    if (lane < 16) L[3072 + 16 * rt + lane] = ss;
                }
                __syncthreads();
                if (tid < 64) { const int t = t0 + tid;
                    float lg[36]; float sq = 0.f;
#pragma unroll
                    for (int j = 0; j < 36; ++j) lg[j] = 0.f;
#pragma unroll
                    for (int w = 0; w < 8; ++w) { const LAS float* Lw = (const LAS float*)(lds + w * 12544); sq += Lw[3072 + tid];
#pragma unroll
                        for (int j = 0; j < 36; ++j) lg[j] += Lw[tid * 48 + j]; }
                    const float r = rsqrtf(sq * (1.f / D) + EPS);
                    rs_ffn[t] = r;
                    LAS float* Lr = L + tid * 48;
#pragma unroll
                    for (int j = 0; j < 36; ++j) Lr[j] = lg[j];
                    float mg = -INFINITY; int gi = 0;
                    for (int j = 0; j < 4; ++j) { const float v = Lr[j] * r + brg[j]; if (v > mg) { mg = v; gi = j; } }
                    float sg = 0.f; for (int j = 0; j < 4; ++j) sg += expf(Lr[j] * r + brg[j] - mg);
                    const float gwt = 1.f / sg;
                    int i1 = 0; float m1 = -INFINITY;
                    for (int j = 0; j < 8; ++j) { const float v = Lr[4 + gi * 8 + j] * r + bre[gi * 8 + j]; if (v > m1) { m1 = v; i1 = j; } }
                    int i2 = 0; float m2 = -INFINITY;
                    for (int j = 0; j < 8; ++j) { const float v = Lr[4 + gi * 8 + j] * r + bre[gi * 8 + j]; if (j != i1 && v > m2) { m2 = v; i2 = j; } }
                    const float p2 = expf(m2 - m1);
                    const float g1 = gwt / (1.f + p2), g2 = gwt * p2 / (1.f + p2);
                    const int e1 = gi * 8 + i1, e2 = gi * 8 + i2;
                    LAS int* lc = (LAS int*)(lds + 8 * 12544); LAS int* lb = lc + 32;
                    if (tid < 32) lc[tid] = 0;
                    asm volatile("s_waitcnt lgkmcnt(0)" ::: "memory"); __builtin_amdgcn_wave_barrier();
                    const int q1 = __hip_atomic_fetch_add(&lc[e1], 1, __ATOMIC_RELAXED, __HIP_MEMORY_SCOPE_WORKGROUP);
                    const int q2 = __hip_atomic_fetch_add(&lc[e2], 1, __ATOMIC_RELAXED, __HIP_MEMORY_SCOPE_WORKGROUP);
                    asm volatile("s_waitcnt lgkmcnt(0)" ::: "memory"); __builtin_amdgcn_wave_barrier();
                    if (tid < 32) { const int n = lc[tid]; lb[tid] = n > 0 ? atomicAdd(&cnt[64 * tid], n) : 0; }
                    asm volatile("s_waitcnt vmcnt(0) lgkmcnt(0)" ::: "memory"); __builtin_amdgcn_wave_barrier();
                    const int s1 = lb[e1] + q1, s2 = lb[e2] + q2;
                    list[(size_t)e1 * CAP + s1] = t; gatel[(size_t)e1 * CAP + s1] = g1;
                    list[(size_t)e2 * CAP + s2] = t; gatel[(size_t)e2 * CAP + s2] = g2;
                    tokrow[t * 4 + 0] = e1; tokrow[t * 4 + 1] = s1; tokrow[t * 4 + 2] = e2; tokrow[t * 4 + 3] = s2;
                }
                __syncthreads();
            }
            SEAM(pb);
        }
        if (IN(pb + 1) || IN(pb + 2)) { PH_ENTER
            int* cnt = (int*)(ctl + CW_CNT) + layer * 4096;
            LAS int* tile_e = (LAS int*)(lds + TAB_TILE_E); LAS int* tile_m = (LAS int*)(lds + TAB_TILE_M); LAS int* ntp = (LAS int*)(lds + TAB_NT);
            LAS int* tokT = (LAS int*)(lds + TAB_TOK); LAS float* gateT = (LAS float*)(lds + TAB_GATE);
            __syncthreads();
            LAS int* cntL = (LAS int*)(lds + TAB_NT + 16);
            if (tid < 64) { const int e = lane & 31; const int c = __hip_atomic_load(&cnt[64 * e], __ATOMIC_RELAXED, __HIP_MEMORY_SCOPE_AGENT); const int mt = (c + 255) >> 8;
                int inc = mt;
#pragma unroll
                for (int o = 1; o < 32; o <<= 1) { const int v = __shfl_up(inc, o, 32); if (e >= o) inc += v; }
                if (tid < 32) { cntL[e] = c; const int st = inc - mt; for (int j = 0; j < mt; ++j) { tile_e[st + j] = e; tile_m[st + j] = j; } if (e == 31) *ntp = inc; } }
            __syncthreads();
            const int ntiles = *ntp;
            for (int i = 0; i < 4; ++i) { const int L = i * G + bx; if (L >= ntiles * 4) break;
                int pm, pn; unit_map(L, ntiles, 4, pm, pn); const int e = tile_e[pm], tm = tile_m[pm];
                const int c = cntL[e];
                if (tid < 256) { const int idx = tm * 256 + tid; const bool ok = idx < c;
                    tokT[i * 256 + tid] = ok ? list[(size_t)e * CAP + idx] : 0; gateT[i * 256 + tid] = ok ? gatel[(size_t)e * CAP + idx] : 0.f; } }
            __syncthreads();
            if (IN(pb + 1)) {
                SchedMoe Sd{ntiles, 4, G, bx, D, (const char*)(ws + WS_WGU + (size_t)layer * WS_MOE_LAYER), (size_t)D * D * 2, tile_e, tokT, tile_m, cntL};
                EpiMoe1 E{Hb, rs_ffn, tokT};
                gemm_phase<EpiMoe1, SchedMoe, true, true>(lds, tid, (const char*)hb, D, Sd, E);
                if (layer == 0) {
                    constexpr int I_EXP = 768; LAS float* scr = (LAS float*)(lds + wave * 16384); const int r = (ntiles * 4) % G;
                    __syncthreads();
                    if (r == 0) { DENSE_ITEMS(gw, NGW, 1608, 3656); EXPERT_ITEMS(gw, NGW, NE * I_EXP, NE * I_EXP + FILL_G1); }
                    else if (bx >= r) { DENSE_ITEMS((bx - r) * 8 + wave, (G - r) * 8, 1608, 3656); EXPERT_ITEMS((bx - r) * 8 + wave, (G - r) * 8, NE * I_EXP, NE * I_EXP + FILL_G1); } }
                SEAM(pb + 1);
            }
            if (IN(pb + 2)) {
                SchedMoe Sd{ntiles, 4, G, bx, DE, (const char*)(ws + WS_WD + (size_t)layer * WS_MOE_LAYER), (size_t)D * DE * 2, tile_e, nullptr, tile_m, cntL};
                EpiMoe2 E{Yb, gateT};
                gemm_phase<EpiMoe2, SchedMoe, true, true>(lds, tid, (const char*)Hb, DE, Sd, E);
                if (layer == 0) {
                    constexpr int I_EXP = 768; LAS float* scr = (LAS float*)(lds + wave * 16384); const int r = (ntiles * 4) % G;
                    __syncthreads();
                    if (r == 0) EXPERT_ITEMS(gw, NGW, NE * I_EXP + FILL_G1, NE * I_EXP + FILL_G1 + FILL_G2);
                    else if (bx >= r) EXPERT_ITEMS((bx - r) * 8 + wave, (G - r) * 8, NE * I_EXP + FILL_G1, NE * I_EXP + FILL_G1 + FILL_G2); }
                SEAM(pb + 2);
            }
        }
        if (IN(pb + 3)) { PH_ENTER
            int* cnt = (int*)(ctl + CW_CNT) + layer * 4096;
            __syncthreads();
            LAS int* pst = (LAS int*)(lds + TAB_TILE_E);
            if (tid < 64) { const int e = lane & 31; const int c = __hip_atomic_load(&cnt[64 * e], __ATOMIC_RELAXED, __HIP_MEMORY_SCOPE_AGENT); const int mt = (c + 255) >> 8;
                int inc = mt;
#pragma unroll
                for (int o = 1; o < 32; o <<= 1) { const int v = __shfl_up(inc, o, 32); if (e >= o) inc += v; }
                if (tid < 32) pst[e] = (inc - mt) << 8; }
            __syncthreads();
            int myr1 = 0, myr2 = 0;
            { const int t = gw + lane * NGW; if (t < T) { const int4 tr = *(const int4*)(tokrow + t * 4); myr1 = pst[tr.x] + tr.y; myr2 = pst[tr.z] + tr.w; } }
            for (int k = 0, t = gw; t < T; ++k, t += NGW) {
                const int r1 = __shfl(myr1, k), r2 = __shfl(myr2, k);
                u32x2* hr = (u32x2*)(hb + (size_t)t * D) + lane; const u32x2* y1 = (const u32x2*)(Yb + (size_t)r1 * D) + lane; const u32x2* y2 = (const u32x2*)(Yb + (size_t)r2 * D) + lane;
                float s = 0.f; f32x4 v[4];
#pragma unroll
                for (int j = 0; j < 4; ++j) { const u32x2 a = y1[64 * j], b = y2[64 * j], c = hr[64 * j]; f32x4 hv;
                    hv.x = bf_lo(c.x) + (bf_lo(a.x) + bf_lo(b.x)); hv.y = bf_hi(c.x) + (bf_hi(a.x) + bf_hi(b.x)); hv.z = bf_lo(c.y) + (bf_lo(a.y) + bf_lo(b.y)); hv.w = bf_hi(c.y) + (bf_hi(a.y) + bf_hi(b.y));
                    v[j] = hv; s += (hv.x * hv.x + hv.y * hv.y) + (hv.z * hv.z + hv.w * hv.w); }
                if (layer == 0) {
                    s = wave_sum(s);
                    if (lane == 0) rs_mix[t] = rsqrtf(s * (1.f / D) + EPS);
#pragma unroll
                    for (int j = 0; j < 4; ++j) hr[64 * j] = (u32x2){cvt_pk_bf16(v[j].x, v[j].y), cvt_pk_bf16(v[j].z, v[j].w)};
                } else {
                    f32x4* ho = (f32x4*)(hout + (size_t)t * D) + lane;
#pragma unroll
                    for (int j = 0; j < 4; ++j) ho[64 * j] = v[j]; }
            }
            if (layer == 0) SEAM(pb + 3);
        }
        if (layer == 0) {
            if (IN(PH_CONVIN)) { PH_ENTER
                SchedPlain Sd{T / BM, CONVN / BM, G, bx, D, (const char*)(ws + WS_WINC)};
                EpiConvIn E{bgate, zcb, rs_mix};
                gemm_phase<EpiConvIn, SchedPlain, true, true>(lds, tid, (const char*)hb, D, Sd, E);
                SEAM(PH_CONVIN);
            }
            if (IN(PH_CONV)) { PH_ENTER
                const float* cw = args.in[18];
                const int c8 = ((bx * 512 + tid) & 127) * 8;
                f32x4 w0[3], w1[3];
#pragma unroll
                for (int k = 0; k < 3; ++k) { w0[k] = *(const f32x4*)(cw + k * D + c8); w1[k] = *(const f32x4*)(cw + k * D + c8 + 4); }
                for (int sl = (bx * 512 + tid) >> 7; sl < T / 16; sl += (G * 512) >> 7) { const int tg0 = sl * 16;
                    u32x4 zr[18], br[16];
#pragma unroll
                    for (int j = 0; j < 18; ++j) { const int tg = tg0 - 2 + j; zr[j] = *(const u32x4*)(zcb + (size_t)(tg < 0 ? 0 : tg) * D + c8); }
#pragma unroll
                    for (int j = 0; j < 16; ++j) br[j] = *(const u32x4*)(bgate + (size_t)(tg0 + j) * D + c8);
                    if ((tg0 % S) == 0) { zr[0] = (u32x4){0u, 0u, 0u, 0u}; zr[1] = zr[0]; }
#pragma unroll
                    for (int j = 0; j < 16; ++j) { f32x4 a0 = (f32x4){0.f, 0.f, 0.f, 0.f}, a1 = a0;
#pragma unroll
                        for (int k = 0; k < 3; ++k) { f32x4 z0, z1; unpack8(zr[j + k], z0, z1); a0 += w0[k] * z0; a1 += w1[k] * z1; }
                        f32x4 b0, b1; unpack8(br[j], b0, b1);
                        st16(g2b + (size_t)(tg0 + j) * D + c8, pack8(b0 * a0, b1 * a1)); }
                }
                SEAM(PH_CONV);
            }
            if (IN(PH_CONVOUT)) { PH_ENTER
                SchedPlain Sd{T / BM, D / BM, G, bx, D, (const char*)(ws + WS_WOUTC)};
                EpiResid E{hb};
                gemm_phase<EpiResid, SchedPlain, true, true>(lds, tid, (const char*)g2b, D, Sd, E);
                SEAM(PH_CONVOUT);
            }
        }
    }
#if DBG
    if (IN(NPHASE - 1)) { PH_ENTER
        xcd_barrier(bar);
        float* acc = (float*)(ctl + CW_DBG);
        const float fn = __hip_atomic_load(acc, __ATOMIC_RELAXED, __HIP_MEMORY_SCOPE_AGENT), fd = __hip_atomic_load(acc + 1, __ATOMIC_RELAXED, __HIP_MEMORY_SCOPE_AGENT);
        if (!(fn <= DBG_TOL * fd) && bx == 0) hout[tid] = __builtin_nanf("");
    }
#endif
#undef IN
#undef SEAM
}
}

extern "C" void kernel_launch(void* const* d_in, const int* in_sizes, int n_in, void* d_out, int out_size, void* d_ws, size_t ws_size, hipStream_t stream) {
    static int grid = 0;
    if (grid == 0) {
        if (n_in != 27 || out_size != T * D || ws_size < WS_END) { fprintf(stderr, "kernel_launch: unexpected shapes (n_in %d out %d ws %zu)\n", n_in, out_size, ws_size); grid = -1; return; }
        int dev = 0, cus = 0, per_cu = 0;
        if (hipGetDevice(&dev) != hipSuccess || hipDeviceGetAttribute(&cus, hipDeviceAttributeMultiprocessorCount, dev) != hipSuccess) { grid = -1; return; }
        if (hipFuncSetAttribute((const void*)fwd, hipFuncAttributeMaxDynamicSharedMemorySize, LDS_BYTES) != hipSuccess) { fprintf(stderr, "kernel_launch: hipFuncSetAttribute failed\n"); grid = -1; return; }
        if (hipOccupancyMaxActiveBlocksPerMultiprocessor(&per_cu, (const void*)fwd, 512, LDS_BYTES) != hipSuccess || per_cu < 1) { fprintf(stderr, "kernel_launch: occupancy query says %d\n", per_cu); }
        (void)hipGetLastError();
        grid = cus;
    }
    if (grid < 0) return;
    (void)hipMemsetAsync((char*)d_ws + WS_CTL, 0, CTL_BYTES, stream);
    Args a{};
    for (int i = 0; i < 27; ++i) a.in[i] = (const float*)d_in[i];
    a.out = (float*)d_out; a.ws = (unsigned char*)d_ws;
    if (NLAUNCH == 1) { a.ph_lo = 0; a.ph_hi = NPHASE; hipLaunchKernelGGL(fwd, dim3(grid), dim3(512), LDS_BYTES, stream, a); }
    else for (int p = 0; p < NPHASE; ++p) { a.ph_lo = p; a.ph_hi = p + 1;
        if ((DRY_MASK >> p) & 1u) { a.dry = DRY_KIND; hipLaunchKernelGGL(fwd, dim3(grid), dim3(512), LDS_BYTES, stream, a); a.dry = 0; }
        const int reps = ((REPEAT_MASK >> p) & 1u) ? 2 : 1;
        for (int r = 0; r < reps; ++r) hipLaunchKernelGGL(fwd, dim3(grid), dim3(512), LDS_BYTES, stream, a); }
}
```

```cpp
#include <hip/hip_runtime.h>
#include <cstdio>
#include <cstdint>

#ifndef NLAUNCH
#define NLAUNCH 1
#endif

#ifndef DRY_MASK
#define DRY_MASK 0u
#endif
#ifndef DRY_KIND
#define DRY_KIND 1
#endif
#ifndef REPEAT_MASK
#define REPEAT_MASK 0u
#endif
#define LAS __attribute__((address_space(3)))
typedef unsigned short bf16_t;
typedef short bf16x8 __attribute__((ext_vector_type(8)));
typedef float f32x4 __attribute__((ext_vector_type(4)));
typedef unsigned u32x4 __attribute__((ext_vector_type(4)));
typedef unsigned u32x2 __attribute__((ext_vector_type(2)));

namespace {
constexpr int D = 1024, NB = 2, S = 8192, T = NB * S;
constexpr int SSMW = 640, NG = 40, GS = 16, NS = 64;
constexpr int AH = 6, HD = 64, AW = 384, MIXIN = 1792, GLUN = 768, CONVN = 3072;
constexpr int NE = 32, DE = 512, CAP = T, MAXROWS = 40960;
constexpr float EPS = 1e-6f;
constexpr int NPHASE = 17;
constexpr int FILL_G1 = 18432, FILL_G2 = 6144;
constexpr int FILL_IN = 3072, FILL_GLU = 3072;
enum { PH_PRO = 0, PH_INPROJ, PH_ATTN, PH_SSMY, PH_GLU, PH_OUT0, PH_RT0, PH_G1_0, PH_G2_0, PH_CMB0, PH_CONVIN, PH_CONV, PH_CONVOUT, PH_RT1, PH_G1_1, PH_G2_1, PH_CMB1 };
#ifndef DBG
#define DBG 0
#endif
#define DBG_TOL 1e-4f

constexpr size_t MiB = 1u << 20;
constexpr size_t WS_CTL = 0, CTL_BYTES = 256 * 1024;
constexpr size_t WS_RSMIX = 1 * MiB, WS_RSFFN = 1 * MiB + 512 * 1024;
constexpr size_t WS_TOKROW = 2 * MiB;
constexpr size_t WS_LIST = 3 * MiB, WS_GATEL = 5 * MiB;
constexpr size_t WS_WRT = 7 * MiB;
constexpr size_t WS_WIN0 = 16 * MiB, WS_WGLU = 20 * MiB, WS_WOUT0 = 21 * MiB, WS_WINC = 23 * MiB, WS_WOUTC = 29 * MiB;
constexpr size_t WS_WGU = 32 * MiB, WS_WD = 96 * MiB, WS_MOE_LAYER = 96 * MiB;
constexpr size_t WS_HB = 224 * MiB;
constexpr size_t WS_PROJ = 256 * MiB, WS_CONCAT = 312 * MiB, WS_YSSM = 344 * MiB;
constexpr size_t WS_BGATE = 256 * MiB, WS_ZC = 288 * MiB, WS_G2 = 320 * MiB;
constexpr size_t WS_H = 364 * MiB, WS_Y = 404 * MiB, WS_END = 494 * MiB;
constexpr size_t WS_UG = 474 * MiB;
constexpr size_t WS_LAM = 404 * MiB  , WS_KF = 406 * MiB  , WS_CT = 408 * MiB  , WS_BEND = 409 * MiB, WS_SEND = 420 * MiB, WS_SIN = 426 * MiB;
constexpr size_t WS_OPART = 432 * MiB, WS_MPART = 470 * MiB, WS_LPART = 472 * MiB;
constexpr size_t WS_DBGA = 364 * MiB, WS_DBGB = 384 * MiB;
constexpr int CW_BAR = 4096;
constexpr int CW_CNT = 16384;
constexpr int CW_DBG = 40960;

constexpr int RING_BYTES = 131072;
constexpr int TAB_OFF = RING_BYTES;
constexpr int TAB_TILE_E = TAB_OFF, TAB_TILE_M = TAB_OFF + 768, TAB_NT = TAB_OFF + 1536, TAB_TOK = TAB_OFF + 2048, TAB_GATE = TAB_OFF + 2048 + 4096;
constexpr int MISC_OFF = TAB_OFF + 2048 + 8192;
constexpr int LDS_BYTES = MISC_OFF + 256;

__device__ __forceinline__ unsigned cvt_pk_bf16(float lo, float hi) { unsigned r; asm volatile("v_cvt_pk_bf16_f32 %0, %1, %2" : "=v"(r) : "v"(lo), "v"(hi)); return r; }
__device__ __forceinline__ float bf_lo(unsigned w) { return __uint_as_float(w << 16); }
__device__ __forceinline__ float bf_hi(unsigned w) { return __uint_as_float(w & 0xffff0000u); }
__device__ __forceinline__ float bf2f(bf16_t b) { return __uint_as_float(((unsigned)b) << 16); }
__device__ __forceinline__ unsigned f2bf(float f) { unsigned u = __float_as_uint(f); return (u + 0x7fffu + ((u >> 16) & 1u)) >> 16; }
__device__ __forceinline__ unsigned pk2(float lo, float hi) { return f2bf(lo) | (f2bf(hi) << 16); }
__device__ __forceinline__ u32x4 pack8(f32x4 a, f32x4 b) { u32x4 w; w.x = cvt_pk_bf16(a[0], a[1]); w.y = cvt_pk_bf16(a[2], a[3]); w.z = cvt_pk_bf16(b[0], b[1]); w.w = cvt_pk_bf16(b[2], b[3]); return w; }
__device__ __forceinline__ void unpack8(u32x4 w, f32x4& a, f32x4& b) { a = (f32x4){bf_lo(w.x), bf_hi(w.x), bf_lo(w.y), bf_hi(w.y)}; b = (f32x4){bf_lo(w.z), bf_hi(w.z), bf_lo(w.w), bf_hi(w.w)}; }
#ifndef WT_STORES
#define WT_STORES 0
#endif
__device__ __forceinline__ void st16(void* p, u32x4 v) {
#if WT_STORES
    asm volatile("global_store_dwordx4 %0, %1, off sc1\n\ts_nop 1" :: "v"(p), "v"(v) : "memory");
#else
    *(u32x4*)p = v;
#endif
}
__device__ __forceinline__ void st16f(void* p, f32x4 v) { st16(p, __builtin_bit_cast(u32x4, v)); }
__device__ __forceinline__ float wave_sum(float v) {
#pragma unroll
    for (int o = 1; o < 64; o <<= 1) v += __shfl_xor(v, o);
    return v;
}
__device__ __forceinline__ float wave_max(float v) {
#pragma unroll
    for (int o = 1; o < 64; o <<= 1) v = fmaxf(v, __shfl_xor(v, o));
    return v;
}
__device__ __forceinline__ float sigmoidf_(float z) { return __builtin_amdgcn_rcpf(1.f + __expf(-z)); }
__device__ __forceinline__ float gelu_tanh(float x) {
    const float z = x * (2.3022082f + 0.10294324f * x * x);
    return x * __builtin_amdgcn_rcpf(1.f + __builtin_amdgcn_exp2f(-z));
}

constexpr int BM = 256, BK = 64, HALF = 128, HTB = HALF * BK * 2, NXCD = 8, WGM = 8;
__host__ __device__ __forceinline__ int lds_byte(int r, int c) { const int st = (r >> 4) * 2 + (c >> 5), rr = r & 15, cc = c & 31, ob = rr * 64 + cc * 2; return st * 1024 + (ob ^ (((ob >> 9) & 1) << 5)); }
__host__ __device__ __forceinline__ void stage_rc(int b, int& R, int& C) { const int st = b / 1024, sb = b % 1024, swz = sb ^ (((sb >> 9) & 1) << 5); R = (st >> 1) * 16 + swz / 64; C = (st & 1) * 32 + (swz % 64) / 2; }
__host__ __device__ __forceinline__ int perm32(int rho) { const int n = rho >> 4, i = rho & 15; return 8 * (i >> 2) + 4 * n + (i & 3); }

struct Unit { int pm, pn, e, half; const char* B; };
__device__ __forceinline__ void unit_map(int L, int nM, int nN, int& pm, int& pn) {
    const int nwg = nM * nN; int wgid = L;
    { const int q = nwg / NXCD, r = nwg % NXCD, xcd = wgid % NXCD, off = wgid / NXCD; wgid = (xcd < r ? xcd * (q + 1) : r * (q + 1) + (xcd - r) * q) + off; }
    const int nig = WGM * nN, gid = wgid / nig, fm = gid * WGM, gsz = (nM - fm) < WGM ? (nM - fm) : WGM;
    pm = fm + ((wgid % nig) % gsz); pn = (wgid % nig) / gsz;
}
struct SchedPlain {
    int nM, nN, G, c, K; const char* Bt;
    __device__ __forceinline__ bool next(int i, Unit& u) const {
        const int L = i * G + c; if (L >= nM * nN) return false;
        unit_map(L, nM, nN, u.pm, u.pn); u.e = 0; u.half = 0; u.B = Bt + (size_t)u.pn * BM * K * 2; return true;
    }
    __device__ __forceinline__ void aoffs(const Unit& u, int, const int (&R)[2], const int (&C)[2], unsigned (&o)[2][2]) const {
#pragma unroll
        for (int h = 0; h < 2; ++h)
#pragma unroll
            for (int i = 0; i < 2; ++i) o[h][i] = (unsigned)(((u.pm * BM + h * HALF + R[i]) * K + C[i]) * 2);
    }
};
struct SchedMoe {
    int ntiles, nN, G, c, K; const char* Bt; size_t strideB; const LAS int* tile_e; const LAS int* tok; const LAS int* tile_m; const LAS int* cntL;
    __device__ __forceinline__ bool next(int i, Unit& u) const {
        const int L = i * G + c; if (L >= ntiles * nN) return false;
        unit_map(L, ntiles, nN, u.pm, u.pn); u.e = tile_e[u.pm]; u.half = (cntL[u.e] - tile_m[u.pm] * 256) <= HALF ? 1 : 0; u.B = Bt + (size_t)u.e * strideB + (size_t)u.pn * BM * K * 2; return true;
    }
    __device__ __forceinline__ void aoffs(const Unit& u, int ui, const int (&R)[2], const int (&C)[2], unsigned (&o)[2][2]) const {
#pragma unroll
        for (int h = 0; h < 2; ++h)
#pragma unroll
            for (int i = 0; i < 2; ++i) {
                const int row = tok ? tok[ui * 256 + h * HALF + R[i]] : (u.pm * BM + h * HALF + R[i]);
                o[h][i] = (unsigned)((row * K + C[i]) * 2);
            }
    }
};

struct SchedSsm {
    int G, c; const char* Bt;
    __device__ __forceinline__ bool next(int i, Unit& u) const {
        const int g = c - (G - NG); if (i != 0 || g < 0) return false;
        u.pm = g; u.pn = 0; u.e = g; u.half = 0; u.B = Bt + (size_t)g * 128 * 1024 * 2; return true;
    }
    __device__ __forceinline__ void aoffs(const Unit& u, int, const int (&R)[2], const int (&C)[2], unsigned (&o)[2][2]) const {
#pragma unroll
        for (int h = 0; h < 2; ++h)
#pragma unroll
            for (int i = 0; i < 2; ++i) o[h][i] = (unsigned)(((u.pm * BM + h * HALF + R[i]) * 1024 + C[i]) * 2);
    }
};
typedef f32x4 Acc[2][2][4][2];

struct EpiProj {
    static constexpr bool PERM = true;
    bf16_t* O; bf16_t* ug; const float* rs; const float* qn; const float* kn;
    __device__ __forceinline__ void operator()(const Acc& acc, const Unit& u, int, int wr, int wc, int fr, int fq) const {
        const int row0 = u.pm * BM + wr * 64 + fr, sigma = u.pn * 4 + wc, col0 = sigma * 64 + 8 * fq;
        const int kind = (sigma >= 10 && sigma < 16) ? 1 : ((sigma >= 16 && sigma < 22) ? 2 : 0);
        f32x4 w[2][2];
#pragma unroll
        for (int bj = 0; bj < 2; ++bj)
#pragma unroll
            for (int n = 0; n < 2; ++n) w[bj][n] = kind ? *(const f32x4*)((kind == 1 ? qn : kn) + 32 * bj + 8 * fq + 4 * n) : (f32x4){1.f, 1.f, 1.f, 1.f};
#pragma unroll
        for (int ai = 0; ai < 2; ++ai)
#pragma unroll
            for (int m = 0; m < 4; ++m) { const int row = row0 + ai * HALF + m * 16; const float s = rs[row];
                f32x4 v[2][2]; float ss = 0.f;
#pragma unroll
                for (int bj = 0; bj < 2; ++bj)
#pragma unroll
                    for (int n = 0; n < 2; ++n) { v[bj][n] = acc[ai][bj][m][n] * s; ss += (v[bj][n][0] * v[bj][n][0] + v[bj][n][1] * v[bj][n][1]) + (v[bj][n][2] * v[bj][n][2] + v[bj][n][3] * v[bj][n][3]); }
                if (kind) { ss += __shfl_xor(ss, 16); ss += __shfl_xor(ss, 32);
                    const float r = rsqrtf(ss * (1.f / HD) + EPS) * (kind == 1 ? 0.125f * 1.4426950408889634f : 1.f);
#pragma unroll
                    for (int bj = 0; bj < 2; ++bj)
#pragma unroll
                        for (int n = 0; n < 2; ++n) v[bj][n] = v[bj][n] * r * w[bj][n]; }
                if (sigma < 10) {
                    bf16_t* up = ug + (((size_t)(4 * sigma + (fq >> 1)) * NB + (row / S)) * S + (row % S)) * GS + 8 * (fq & 1);
#pragma unroll
                    for (int bj = 0; bj < 2; ++bj) st16(up + (size_t)2 * bj * NB * S * GS, pack8(v[bj][0], v[bj][1]));
                } else { bf16_t* rowp = O + (size_t)row * MIXIN + col0;
#pragma unroll
                    for (int bj = 0; bj < 2; ++bj) st16(rowp + 32 * bj, pack8(v[bj][0], v[bj][1])); } }
    }
};
struct EpiSend {
    static constexpr bool PERM = true;
    float* send;
    __device__ __forceinline__ void operator()(const Acc& acc, const Unit& u, int, int wr, int wc, int fr, int fq) const {
#pragma unroll
        for (int ai = 0; ai < 2; ++ai)
#pragma unroll
            for (int m = 0; m < 4; ++m) { const int c = wr * 64 + m * 16 + fr;
                float* o = send + ((size_t)(ai * NG + u.pm) * 128 + c) * 128 + wc * 32 + 8 * fq;
                st16f(o, acc[ai][0][m][0]); st16f(o + 4, acc[ai][0][m][1]); }
    }
};
struct EpiGlu {
    static constexpr bool PERM = true;
    const bf16_t* y; bf16_t* O; const float* bias;
    __device__ __forceinline__ void operator()(const Acc& acc, const Unit& u, int, int wr, int wc, int fr, int fq) const {
        const int row0 = u.pm * BM + wr * 64 + fr, col0 = u.pn * BM + wc * 32 + 8 * fq;
#pragma unroll
        for (int bj = 0; bj < 2; ++bj) {
            const int col = col0 + bj * HALF; if (col >= SSMW) continue;
            const f32x4 b0 = *(const f32x4*)(bias + col), b1 = *(const f32x4*)(bias + col + 4);
#pragma unroll
            for (int ai = 0; ai < 2; ++ai)
#pragma unroll
                for (int m = 0; m < 4; ++m) { const int row = row0 + ai * HALF + m * 16;
                    f32x4 y0, y1; unpack8(*(const u32x4*)(y + (size_t)row * SSMW + col), y0, y1);
                    const f32x4 z0 = acc[ai][bj][m][0] + b0, z1 = acc[ai][bj][m][1] + b1;
                    f32x4 o0, o1;
#pragma unroll
                    for (int j = 0; j < 4; ++j) { o0[j] = y0[j] * sigmoidf_(z0[j]); o1[j] = y1[j] * sigmoidf_(z1[j]); }
                    st16(O + (size_t)row * D + col, pack8(o0, o1)); }
        }
    }
};
struct EpiResid {
    static constexpr bool PERM = true;
    bf16_t* hb;
    __device__ __forceinline__ void operator()(const Acc& acc, const Unit& u, int, int wr, int wc, int fr, int fq) const {
        const int row0 = u.pm * BM + wr * 64 + fr, col0 = u.pn * BM + wc * 32 + 8 * fq;
#pragma unroll
        for (int ai = 0; ai < 2; ++ai)
#pragma unroll
            for (int m = 0; m < 4; ++m) { const size_t off = (size_t)(row0 + ai * HALF + m * 16) * D + col0;
#pragma unroll
                for (int bj = 0; bj < 2; ++bj) { const size_t o = off + bj * HALF;
                    f32x4 r0, r1; unpack8(*(const u32x4*)(hb + o), r0, r1);
                    st16(hb + o, pack8(r0 + acc[ai][bj][m][0], r1 + acc[ai][bj][m][1])); } }
    }
};
struct EpiMoe1 {
    static constexpr bool PERM = true;
    bf16_t* H; const float* rs; const LAS int* tok;
    __device__ __forceinline__ void operator()(const Acc& acc, const Unit& u, int ui, int wr, int wc, int fr, int fq) const {
        const int r0 = wr * 64 + fr, col0 = u.pn * HALF + wc * 32 + 8 * fq;
#pragma unroll
        for (int ai = 0; ai < 2; ++ai)
#pragma unroll
            for (int m = 0; m < 4; ++m) { const int r = r0 + ai * HALF + m * 16; const float s = rs[tok[ui * 256 + r]];
                f32x4 o0, o1;
#pragma unroll
                for (int j = 0; j < 4; ++j) { const float g0 = acc[ai][0][m][0][j] * s, g1 = acc[ai][0][m][1][j] * s;
                    o0[j] = g0 * sigmoidf_(g0) * (acc[ai][1][m][0][j] * s); o1[j] = g1 * sigmoidf_(g1) * (acc[ai][1][m][1][j] * s); }
                st16(H + (size_t)(u.pm * BM + r) * DE + col0, pack8(o0, o1)); }
    }
};
struct EpiMoe2 {
    static constexpr bool PERM = true;
    bf16_t* Y; const LAS float* gate;
    __device__ __forceinline__ void operator()(const Acc& acc, const Unit& u, int ui, int wr, int wc, int fr, int fq) const {
        const int r0 = wr * 64 + fr, col0 = u.pn * BM + wc * 32 + 8 * fq;
#pragma unroll
        for (int ai = 0; ai < 2; ++ai)
#pragma unroll
            for (int m = 0; m < 4; ++m) { const int r = r0 + ai * HALF + m * 16; const float s = gate[ui * 256 + r]; bf16_t* rowp = Y + (size_t)(u.pm * BM + r) * D + col0;
#pragma unroll
                for (int bj = 0; bj < 2; ++bj) st16(rowp + bj * HALF, pack8(acc[ai][bj][m][0] * s, acc[ai][bj][m][1] * s)); }
    }
};
struct EpiConvIn {
    static constexpr bool PERM = true;
    bf16_t* bg; bf16_t* zc; const float* rs;
    __device__ __forceinline__ void operator()(const Acc& acc, const Unit& u, int, int wr, int wc, int fr, int fq) const {
        const int row0 = u.pm * BM + wr * 64 + fr;
#pragma unroll
        for (int ai = 0; ai < 2; ++ai)
#pragma unroll
            for (int m = 0; m < 4; ++m) { const int row = row0 + ai * HALF + m * 16; const float s = rs[row];
                if (u.pn < 4) { bf16_t* rowp = bg + (size_t)row * D + u.pn * BM + wc * 32 + 8 * fq;
#pragma unroll
                    for (int bj = 0; bj < 2; ++bj) st16(rowp + bj * HALF, pack8(acc[ai][bj][m][0] * s, acc[ai][bj][m][1] * s));
                } else { const float s2 = s * s;
                    st16(zc + (size_t)row * D + (u.pn - 4) * HALF + wc * 32 + 8 * fq, pack8(acc[ai][0][m][0] * acc[ai][1][m][0] * s2, acc[ai][0][m][1] * acc[ai][1][m][1] * s2)); } }
    }
};

template <class Epi, class Sched, bool ALIGN_EPI, bool SP2>
__device__ __forceinline__ void gemm_phase(LAS unsigned char* lds, const int tid, const char* Abase, const int K, const Sched& S, const Epi& E) {
    const int wid = __builtin_amdgcn_readfirstlane(tid >> 6), lane = tid & 63, wr = wid >> 2, wc = wid & 3, fr = lane & 15, fq = lane >> 4;
    const int nt = K / BK;
    int Rr[2], Cc[2]; unsigned voffB[2];
#pragma unroll
    for (int i = 0; i < 2; ++i) { int R, C; stage_rc(tid * 16 + i * 8192, R, C); Rr[i] = R; Cc[i] = C; const int Rb = Epi::PERM ? ((R & ~31) + perm32(R & 31)) : R; voffB[i] = (unsigned)(Rb * K + C) * 2u; }
    const size_t kstep = (size_t)(BK * 2);
    const size_t hstep = (size_t)HALF * K * 2;
    const unsigned ldsw = (unsigned)wid * 1024u;
    const int aoff = lds_byte(wr * 64 + fr, fq * 8), boff = lds_byte(wc * 32 + fr, fq * 8);
#define PG8_SA(b, h) (((b) * 2 + (h)) * HTB)
#define PG8_SB(b, h) ((4 + (b) * 2 + (h)) * HTB)
#define PG8_STAGEB(bufoff, gbase) do { _Pragma("unroll") for (int _i = 0; _i < 2; ++_i) \
        __builtin_amdgcn_global_load_lds((const unsigned*)((const char*)(gbase) + voffB[_i]), (LAS unsigned*)(lds + (bufoff) + ldsw + _i * 8192), 16, 0, 0); } while (0)
#define PG8_STAGEA(bufoff, kb, offs, h) do { _Pragma("unroll") for (int _i = 0; _i < 2; ++_i) \
        __builtin_amdgcn_global_load_lds((const unsigned*)(Abase + (size_t)(kb) + (offs)[h][_i]), (LAS unsigned*)(lds + (bufoff) + ldsw + _i * 8192), 16, 0, 0); } while (0)
#define PG8_LDA(dst, b, h) do { _Pragma("unroll") for (int m = 0; m < 4; ++m) _Pragma("unroll") for (int k = 0; k < 2; ++k) dst[m][k] = *(const LAS bf16x8*)(lds + PG8_SA(b, h) + aoff + m * 2048 + k * 1024); } while (0)
#define PG8_LDB(dst, b, h) do { _Pragma("unroll") for (int n = 0; n < 2; ++n) _Pragma("unroll") for (int k = 0; k < 2; ++k) dst[n][k] = *(const LAS bf16x8*)(lds + PG8_SB(b, h) + boff + n * 2048 + k * 1024); } while (0)
#define PG8_MMA(ai, bj, At, Bt) do { __builtin_amdgcn_s_setprio(1); _Pragma("unroll") for (int m = 0; m < 4; ++m) _Pragma("unroll") for (int n = 0; n < 2; ++n) _Pragma("unroll") for (int k = 0; k < 2; ++k) \
        acc[ai][bj][m][n] = __builtin_amdgcn_mfma_f32_16x16x32_bf16(Bt[n][k], At[m][k], acc[ai][bj][m][n], 0, 0, 0); __builtin_amdgcn_s_setprio(0); } while (0)
#define PG8_WAIT_V(n) asm volatile("s_waitcnt vmcnt(" #n ")" ::: "memory")
#define PG8_WAIT_L(n) asm volatile("s_waitcnt lgkmcnt(" #n ")" ::: "memory")
#define PG8_BAR __builtin_amdgcn_s_barrier()
#define PG8_SCHED __builtin_amdgcn_sched_barrier(0)
    Unit cur, nxt; int ui = 0;
    if (!S.next(0, cur)) return;
    Acc acc;
#pragma unroll
    for (int a = 0; a < 2; ++a)
#pragma unroll
        for (int b = 0; b < 2; ++b)
#pragma unroll
            for (int m = 0; m < 4; ++m)
#pragma unroll
                for (int n = 0; n < 2; ++n) acc[a][b][m][n] = (f32x4){0.f, 0.f, 0.f, 0.f};
    bf16x8 At[4][2], B0[2][2], B1[2][2];
    unsigned ca[2][2], na[2][2];
    S.aoffs(cur, 0, Rr, Cc, ca);
    const char* cB = cur.B;
    if constexpr (SP2) {
        PG8_STAGEB(PG8_SB(0, 0), cB); PG8_STAGEB(PG8_SB(0, 1), cB + hstep); PG8_STAGEA(PG8_SA(0, 0), 0, ca, 0); PG8_STAGEA(PG8_SA(0, 1), 0, ca, 1);
        if (wr == 1) PG8_BAR;
        PG8_WAIT_V(2); PG8_BAR;
        PG8_STAGEB(PG8_SB(1, 0), cB + kstep); PG8_STAGEA(PG8_SA(1, 0), kstep, ca, 0); PG8_STAGEB(PG8_SB(1, 1), cB + hstep + kstep);
        PG8_WAIT_V(6); PG8_BAR;
    } else {
        PG8_STAGEB(PG8_SB(0, 0), cB); PG8_STAGEA(PG8_SA(0, 0), 0, ca, 0); PG8_STAGEB(PG8_SB(0, 1), cB + hstep); PG8_STAGEA(PG8_SA(0, 1), 0, ca, 1);
        if (wr == 1) PG8_BAR;
        PG8_WAIT_V(4); PG8_BAR;
        PG8_STAGEB(PG8_SB(1, 0), cB + kstep); PG8_STAGEA(PG8_SA(1, 0), kstep, ca, 0); PG8_STAGEB(PG8_SB(1, 1), cB + hstep + kstep);
        PG8_WAIT_V(6); PG8_BAR;
    }
    for (;;) {
        const bool has_next = S.next(ui + 1, nxt);
        if (has_next) S.aoffs(nxt, ui + 1, Rr, Cc, na);
        else {
#pragma unroll
            for (int h = 0; h < 2; ++h)
#pragma unroll
                for (int i = 0; i < 2; ++i) na[h][i] = ca[h][i];
        }
        const char* nB = has_next ? nxt.B : cB;
        for (int t = 0; t < nt; t += 2) {
            const bool last = (t == nt - 2);
            const size_t k1 = (size_t)(t + 1) * kstep;
            const size_t k2 = last ? 0 : (size_t)(t + 2) * kstep, k3 = k2 + kstep;
            unsigned o2[2][2];
#pragma unroll
            for (int h = 0; h < 2; ++h)
#pragma unroll
                for (int i = 0; i < 2; ++i) o2[h][i] = last ? na[h][i] : ca[h][i];
            const char* b2 = last ? nB : cB + (size_t)(t + 2) * kstep; const char* b3 = b2 + kstep;
            if constexpr (SP2) {
            PG8_LDB(B0, 0, 0); PG8_LDB(B1, 0, 1); PG8_SCHED; PG8_LDA(At, 0, 0); PG8_STAGEA(PG8_SA(1, 1), k1, ca, 1);
            PG8_WAIT_V(8); PG8_WAIT_L(0); PG8_BAR; PG8_MMA(0, 0, At, B0); PG8_MMA(0, 1, At, B1); PG8_BAR; PG8_SCHED;
            PG8_LDA(At, 0, 1); PG8_STAGEB(PG8_SB(0, 0), b2); PG8_STAGEB(PG8_SB(0, 1), b2 + hstep); PG8_STAGEA(PG8_SA(0, 0), k2, o2, 0);
            PG8_WAIT_V(8); PG8_WAIT_L(0); PG8_BAR; if (!cur.half) { PG8_MMA(1, 0, At, B0); PG8_MMA(1, 1, At, B1); } PG8_BAR; PG8_SCHED;
            PG8_LDB(B0, 1, 0); PG8_LDB(B1, 1, 1); PG8_SCHED; PG8_LDA(At, 1, 0); PG8_STAGEA(PG8_SA(0, 1), k2, o2, 1);
            PG8_WAIT_V(8); PG8_WAIT_L(0); PG8_BAR; PG8_MMA(0, 0, At, B0); PG8_MMA(0, 1, At, B1); PG8_BAR; PG8_SCHED;
            PG8_LDA(At, 1, 1); PG8_STAGEB(PG8_SB(1, 0), b3); PG8_STAGEB(PG8_SB(1, 1), b3 + hstep); PG8_STAGEA(PG8_SA(1, 0), k3, o2, 0);
            PG8_WAIT_V(8); PG8_WAIT_L(0); PG8_BAR; if (!cur.half) { PG8_MMA(1, 0, At, B0); PG8_MMA(1, 1, At, B1); } PG8_BAR; PG8_SCHED;
            } else {
            PG8_LDB(B0, 0, 0); PG8_SCHED; PG8_LDA(At, 0, 0); PG8_STAGEA(PG8_SA(1, 1), k1, ca, 1);
            PG8_WAIT_L(8); PG8_BAR; PG8_WAIT_L(0); PG8_MMA(0, 0, At, B0); PG8_BAR; PG8_SCHED;
            PG8_LDB(B1, 0, 1); PG8_STAGEB(PG8_SB(0, 0), b2);
            PG8_BAR; PG8_WAIT_L(0); PG8_MMA(0, 1, At, B1); PG8_BAR;
            PG8_LDA(At, 0, 1); PG8_STAGEA(PG8_SA(0, 0), k2, o2, 0);
            PG8_BAR; PG8_WAIT_L(0); PG8_MMA(1, 0, At, B0); PG8_BAR; PG8_SCHED;
            PG8_STAGEB(PG8_SB(0, 1), b2 + hstep);
            PG8_WAIT_V(6); PG8_BAR; PG8_MMA(1, 1, At, B1); PG8_BAR;
            PG8_LDB(B0, 1, 0); PG8_SCHED; PG8_LDA(At, 1, 0); PG8_STAGEA(PG8_SA(0, 1), k2, o2, 1);
            PG8_WAIT_L(8); PG8_BAR; PG8_WAIT_L(0); PG8_MMA(0, 0, At, B0); PG8_BAR; PG8_SCHED;
            PG8_LDB(B1, 1, 1); PG8_STAGEB(PG8_SB(1, 0), b3);
            PG8_BAR; PG8_WAIT_L(0); PG8_MMA(0, 1, At, B1); PG8_BAR;
            PG8_LDA(At, 1, 1); PG8_STAGEA(PG8_SA(1, 0), k3, o2, 0);
            PG8_BAR; PG8_WAIT_L(0); PG8_MMA(1, 0, At, B0); PG8_BAR; PG8_SCHED;
            PG8_STAGEB(PG8_SB(1, 1), b3 + hstep);
            PG8_WAIT_V(6); PG8_BAR; PG8_MMA(1, 1, At, B1); PG8_BAR;
            }
        }
        if constexpr (ALIGN_EPI) { if (wr == 0) PG8_BAR; }
        E(acc, cur, ui, wr, wc, fr, fq);
        if (!has_next) break;
#pragma unroll
        for (int a = 0; a < 2; ++a)
#pragma unroll
            for (int b = 0; b < 2; ++b)
#pragma unroll
                for (int m = 0; m < 4; ++m)
#pragma unroll
                    for (int n = 0; n < 2; ++n) acc[a][b][m][n] = (f32x4){0.f, 0.f, 0.f, 0.f};
        cur = nxt; cB = nB; ++ui;
#pragma unroll
        for (int h = 0; h < 2; ++h)
#pragma unroll
            for (int i = 0; i < 2; ++i) ca[h][i] = na[h][i];
        if constexpr (ALIGN_EPI) { if (wr == 1) PG8_BAR; }
    }
    PG8_WAIT_V(0);
    if constexpr (!ALIGN_EPI) { if (wr == 0) PG8_BAR; }
    PG8_BAR;
#undef PG8_SA
#undef PG8_SB
#undef PG8_STAGEA
#undef PG8_STAGEB
#undef PG8_LDA
#undef PG8_LDB
#undef PG8_MMA
#undef PG8_WAIT_V
#undef PG8_WAIT_L
#undef PG8_BAR
#undef PG8_SCHED
}

#define XB_TMO      128
#define XB_XCNT(j)  (256  + 64 * (j))
#define XB_XSUB(j)  (1280 + 64 * (j))
#define XB_XGEN(j)  (2304 + 64 * (j))
#define XB_TOP      3328
#define XB_TOPGEN   3392
#define XCD_BAR_WORDS 3456
#define XB_SPIN_CAP (1u << 18)
__device__ __forceinline__ unsigned xb_ld(unsigned* p)              { return __hip_atomic_load(p, __ATOMIC_RELAXED, __HIP_MEMORY_SCOPE_AGENT); }
__device__ __forceinline__ unsigned xb_add(unsigned* p, unsigned v) { return __hip_atomic_fetch_add(p, v, __ATOMIC_RELAXED, __HIP_MEMORY_SCOPE_AGENT); }
__device__ __forceinline__ unsigned xb_xcc_id() { return (unsigned)__builtin_amdgcn_s_getreg((3 << 11) | 20) & 0xFu; }
#define XB_SPIN(cond, bar) do { unsigned _sp = 0; while (cond) { __builtin_amdgcn_s_sleep(1); \
    if ((++_sp & 255u) == 0u) { if (xb_ld(&(bar)[XB_TMO])) break; if (_sp > XB_SPIN_CAP) { atomicAdd(&(bar)[XB_TMO], 1u); break; } } } } while (0)
struct XcdBarrier { unsigned* bar; unsigned x; volatile LAS unsigned* st; };
__device__ __forceinline__ XcdBarrier xcd_barrier_post(unsigned* bar, volatile LAS unsigned* st) {
    XcdBarrier b; b.bar = bar; b.x = xb_xcc_id(); b.st = st;
    if (threadIdx.x == 0) (void)xb_add(&bar[XB_XCNT(b.x)], 1u);
    return b;
}
__device__ __forceinline__ void xcd_barrier_complete(unsigned* bar, unsigned x, unsigned& nloc, unsigned& nx) {
    const unsigned G = gridDim.x * gridDim.y * gridDim.z;
    unsigned sum, cnt, mine, sp = 0u;
    for (;;) {
        sum = 0u; cnt = 0u; mine = 0u;
#pragma unroll
        for (unsigned j = 0; j < 16; ++j) { const unsigned c = xb_ld(&bar[XB_XCNT(j)]); sum += c; cnt += (c > 0u) ? 1u : 0u; mine = (j == x) ? c : mine; }
        if (sum == G) break;
        __builtin_amdgcn_s_sleep(1);
        if ((++sp & 255u) == 0u) { if (xb_ld(&bar[XB_TMO])) break; if (sp > XB_SPIN_CAP) { atomicAdd(&bar[XB_TMO], 1u); break; } }
    }
    nloc = mine > 0u ? mine : 1u; nx = cnt > 0u ? cnt : 1u;
}
__device__ __forceinline__ void xcd_barrier(const XcdBarrier& b) {
    asm volatile("s_waitcnt vmcnt(0)" ::: "memory");
    __syncthreads();
    if (threadIdx.x == 0) {
        unsigned* bar = b.bar;
        __builtin_amdgcn_s_waitcnt(0);
        unsigned nloc = b.st[0], nx = b.st[1];
        if (nloc == 0u) { xcd_barrier_complete(bar, b.x, nloc, nx); b.st[0] = nloc; b.st[1] = nx; }
        const unsigned old = xb_add(&bar[XB_XSUB(b.x)], 1u);
        const unsigned gen = old / nloc;
        if (old + 1u == (gen + 1u) * nloc) {
            __builtin_amdgcn_fence(__ATOMIC_RELEASE, "agent");
            asm volatile("s_waitcnt vmcnt(0)" ::: "memory");
            const unsigned og = xb_add(&bar[XB_TOP], 1u);
            const unsigned tg = og / nx;
            if (og + 1u == (tg + 1u) * nx) xb_add(&bar[XB_TOPGEN], 1u);
            else XB_SPIN(xb_ld(&bar[XB_TOPGEN]) == tg, bar);
            __builtin_amdgcn_fence(__ATOMIC_ACQUIRE, "agent");
            xb_add(&bar[XB_XGEN(b.x)], 1u);
            asm volatile("s_waitcnt vmcnt(0)" ::: "memory");
        } else {
            XB_SPIN(xb_ld(&bar[XB_XGEN(b.x)]) == gen, bar);
            __builtin_amdgcn_fence(__ATOMIC_ACQUIRE, "agent");
            asm volatile("s_waitcnt vmcnt(0)" ::: "memory");
        }
    }
    __syncthreads();
}

struct Args { const float* in[27]; float* out; unsigned char* ws; int ph_lo, ph_hi, dry, pad; };
typedef float f32x16 __attribute__((ext_vector_type(16)));
typedef short s16x4 __attribute__((ext_vector_type(4)));

__device__ __forceinline__ void tr_item(const float* W, int ldn, int K, int k0, int n0, bf16_t* WT, int orow0, const float* gk, LAS float* scr, int lane) {
    float v[32];
    const float* src = W + (size_t)(k0 + (lane >> 5)) * ldn + n0 + (lane & 31);
#pragma unroll
    for (int i = 0; i < 32; ++i) v[i] = src[(size_t)(2 * i) * ldn];
    const int c = lane & 7;
    f32x4 g0 = (f32x4){1.f, 1.f, 1.f, 1.f}, g1 = g0;
    if (gk) { g0 = *(const f32x4*)(gk + k0 + 8 * c); g1 = *(const f32x4*)(gk + k0 + 8 * c + 4); }
#pragma unroll
    for (int i = 0; i < 32; ++i) scr[(2 * i + (lane >> 5)) * 33 + (lane & 31)] = v[i];
    asm volatile("s_waitcnt lgkmcnt(0)" ::: "memory");
#pragma unroll
    for (int j = 0; j < 4; ++j) { const int n = (lane >> 3) + 8 * j; const LAS float* s = scr + (8 * c) * 33 + n;
        u32x4 o; o.x = pk2(s[0 * 33] * g0[0], s[1 * 33] * g0[1]); o.y = pk2(s[2 * 33] * g0[2], s[3 * 33] * g0[3]); o.z = pk2(s[4 * 33] * g1[0], s[5 * 33] * g1[1]); o.w = pk2(s[6 * 33] * g1[2], s[7 * 33] * g1[3]);
        st16(WT + (size_t)(orow0 + n) * K + k0 + 8 * c, o); }
    asm volatile("s_waitcnt lgkmcnt(0)" ::: "memory");
}
__device__ __forceinline__ void conv_matrix(const float* W, int K, int N, bf16_t* WT, const float* gk, int mode, int item, LAS float* scr, int lane) {
    const int nnb = N / 32, kb = item / nnb, nb = item % nnb, k0 = kb * 64, n0 = nb * 32;
    int orow = n0;
    if (mode == 1) orow = 256 * (n0 >> 7) + (n0 & 127);
    else if (mode == 2) orow = 256 * (n0 >> 7) + 128 + (n0 & 127);
    else if (mode == 3) {
        if (n0 >= 2 * D) { const int cc = n0 - 2 * D; orow = 256 * (4 + (cc >> 7)) + 128 + (cc & 127); }
        else if (n0 >= D) { const int cc = n0 - D; orow = 256 * (4 + (cc >> 7)) + (cc & 127); }
    } else if (mode == 4) { const int sg = n0 >> 6; orow = 256 * (sg >> 2) + 128 * ((n0 >> 5) & 1) + 32 * (sg & 3); }
    tr_item(W, N, K, k0, n0, WT, orow, gk, scr, lane);
}
struct CvIt { const float* src; bf16_t* dst; const float* gk; int ldn, K; };
__device__ __forceinline__ CvIt cv_desc(const float* W, int K, int N, bf16_t* WT, const float* gk, int mode, int item, int lane) {
    const int nnb = N / 32, kb = item / nnb, nb = item % nnb, k0 = kb * 64, n0 = nb * 32;
    int orow = n0;
    if (mode == 1) orow = 256 * (n0 >> 7) + (n0 & 127);
    else if (mode == 2) orow = 256 * (n0 >> 7) + 128 + (n0 & 127);
    CvIt d; d.src = W + (size_t)(k0 + (lane >> 5)) * N + n0 + (lane & 31); d.dst = WT + (size_t)orow * K + k0; d.gk = gk ? gk + k0 : nullptr; d.ldn = N; d.K = K; return d;
}
__device__ __forceinline__ CvIt cv_expert(const float* wg, const float* wu, const float* wdn, const float* gffn, unsigned char* ws, int it, int lane) {
    constexpr int I_EXP = 768;
    const int le = it / I_EXP, layer = le / NE, e = le % NE, r = it % I_EXP;
    bf16_t* wgu = (bf16_t*)(ws + WS_WGU + (size_t)layer * WS_MOE_LAYER) + (size_t)e * D * D;
    bf16_t* wd = (bf16_t*)(ws + WS_WD + (size_t)layer * WS_MOE_LAYER) + (size_t)e * D * DE;
    const size_t eoff = ((size_t)layer * NE + e) * D * DE;
    if (r < 256) return cv_desc(wg + eoff, D, DE, wgu, gffn + layer * D, 1, r, lane);
    if (r < 512) return cv_desc(wu + eoff, D, DE, wgu, gffn + layer * D, 2, r - 256, lane);
    return cv_desc(wdn + eoff, DE, D, wd, nullptr, 0, r - 512, lane);
}
__device__ __forceinline__ void cv_load(const CvIt& d, float (&v)[32], f32x4& g0, f32x4& g1, int lane) {
#pragma unroll
    for (int i = 0; i < 32; ++i) v[i] = d.src[(size_t)(2 * i) * d.ldn];
    g0 = (f32x4){1.f, 1.f, 1.f, 1.f}; g1 = g0;
    if (d.gk) { g0 = *(const f32x4*)(d.gk + 8 * (lane & 7)); g1 = *(const f32x4*)(d.gk + 8 * (lane & 7) + 4); }
}
__device__ __forceinline__ void cv_store(const CvIt& d, const float (&v)[32], const f32x4 g0, const f32x4 g1, LAS float* scr, int lane) {
#pragma unroll
    for (int i = 0; i < 32; ++i) scr[(2 * i + (lane >> 5)) * 33 + (lane & 31)] = v[i];
    asm volatile("s_waitcnt lgkmcnt(0)" ::: "memory");
    const int c = lane & 7;
#pragma unroll
    for (int j = 0; j < 4; ++j) { const int n = (lane >> 3) + 8 * j; const LAS float* s = scr + (8 * c) * 33 + n;
        u32x4 o; o.x = pk2(s[0 * 33] * g0[0], s[1 * 33] * g0[1]); o.y = pk2(s[2 * 33] * g0[2], s[3 * 33] * g0[3]); o.z = pk2(s[4 * 33] * g1[0], s[5 * 33] * g1[1]); o.w = pk2(s[6 * 33] * g1[2], s[7 * 33] * g1[3]);
        st16(d.dst + (size_t)n * d.K + 8 * c, o); }
    asm volatile("s_waitcnt lgkmcnt(0)" ::: "memory");
}
__device__ __forceinline__ void cpow(float lre, float lim, float step, float n, float& wr, float& wi) {
    const float er = expf(n * lre * step), ang = n * lim * step; wr = er * cosf(ang); wi = er * sinf(ang);
}
__device__ __forceinline__ f32x4 mfma16(bf16x8 a, bf16x8 b, f32x4 c) { return __builtin_amdgcn_mfma_f32_16x16x32_bf16(a, b, c, 0, 0, 0); }
__device__ __forceinline__ f32x16 mfma32(bf16x8 a, bf16x8 b, f32x16 c) { return __builtin_amdgcn_mfma_f32_32x32x16_bf16(a, b, c, 0, 0, 0); }
__device__ __forceinline__ s16x4 vtr(LAS unsigned char* p) { return __builtin_bit_cast(s16x4, __builtin_amdgcn_ds_read_tr16_b64_v4i16((LAS s16x4*)p)); }

__global__ void __launch_bounds__(512, 2) fwd(Args args) {
    extern __shared__ __attribute__((aligned(16))) unsigned char lds_raw[];
    LAS unsigned char* lds = (LAS unsigned char*)lds_raw;
    const int G = gridDim.x, bx = blockIdx.x, NGW = G * 8;
    volatile LAS unsigned* MISC = (volatile LAS unsigned*)(lds + MISC_OFF);
    if (threadIdx.x < 64) MISC[threadIdx.x] = 0u;
    __syncthreads();
    XcdBarrier bar; bar.bar = (unsigned*)(args.ws + WS_CTL) + CW_BAR; bar.x = 0; bar.st = nullptr;
    if (NLAUNCH == 1) bar = xcd_barrier_post((unsigned*)(args.ws + WS_CTL) + CW_BAR, MISC);
    const int lo = args.ph_lo, hi = args.ph_hi;
#define IN(k) (lo <= (k) && (k) < hi)
#define SEAM(k) do { if (NLAUNCH == 1 && IN((k) + 1)) xcd_barrier(bar); } while (0)
#define PH_ENTER \
    int tid = threadIdx.x; asm volatile("" : "+v"(tid)); \
    const int lane = tid & 63, wave = __builtin_amdgcn_readfirstlane(tid >> 6), gw = bx * 8 + wave; \
    unsigned char* ws = args.ws; asm volatile("" : "+s"(ws)); \
    float* hout = args.out; asm volatile("" : "+s"(hout)); \
    unsigned* ctl = (unsigned*)(ws + WS_CTL); (void)ctl; (void)lane; (void)gw; \
    float* rs_mix = (float*)(ws + WS_RSMIX); float* rs_ffn = (float*)(ws + WS_RSFFN); (void)rs_mix; (void)rs_ffn; \
    int* tokrow = (int*)(ws + WS_TOKROW); int* list = (int*)(ws + WS_LIST); float* gatel = (float*)(ws + WS_GATEL); (void)tokrow; (void)list; (void)gatel; \
    bf16_t* hb = (bf16_t*)(ws + WS_HB); (void)hb; \
    bf16_t* proj = (bf16_t*)(ws + WS_PROJ); bf16_t* concat = (bf16_t*)(ws + WS_CONCAT); bf16_t* yssm = (bf16_t*)(ws + WS_YSSM); (void)proj; (void)concat; (void)yssm; \
    bf16_t* bgate = (bf16_t*)(ws + WS_BGATE); bf16_t* zcb = (bf16_t*)(ws + WS_ZC); bf16_t* g2b = (bf16_t*)(ws + WS_G2); (void)bgate; (void)zcb; (void)g2b; \
    bf16_t* Hb = (bf16_t*)(ws + WS_H); bf16_t* Yb = (bf16_t*)(ws + WS_Y); (void)Hb; (void)Yb;

    if (IN(PH_PRO)) { PH_ENTER
        const float* x = args.in[0];
        LAS float* scr = (LAS float*)(lds + wave * 16384);
        constexpr int I_IN0 = 16 * 56, I_GLU = 10 * 20, I_O0 = 16 * 32, I_INC = 16 * 96, I_OC = 16 * 32, I_DENSE = I_IN0 + I_GLU + I_O0 + I_INC + I_OC;
        constexpr int I_EXP = 768, NITEMS = I_DENSE + NE * I_EXP;
#define EXPERT_ITEMS(gw_, ngw_, first_, last_) do { for (int it_ = (first_) + (gw_); it_ < (last_); it_ += 2 * (ngw_)) { \
            const bool hb_ = it_ + (ngw_) < (last_); \
            const CvIt da_ = cv_expert(args.in[24], args.in[25], args.in[26], args.in[2], ws, it_, lane), db_ = cv_expert(args.in[24], args.in[25], args.in[26], args.in[2], ws, hb_ ? it_ + (ngw_) : it_, lane); \
            float va_[32], vb_[32]; f32x4 ga0_, ga1_, gb0_, gb1_; \
            cv_load(da_, va_, ga0_, ga1_, lane); cv_load(db_, vb_, gb0_, gb1_, lane);            \
            cv_store(da_, va_, ga0_, ga1_, scr, lane); if (hb_) cv_store(db_, vb_, gb0_, gb1_, scr, lane); } } while (0)
#define DENSE_ITEMS(gw_, ngw_, first_, last_) do { for (int it_ = (first_) + (gw_); it_ < (last_); it_ += (ngw_)) { int r_ = it_; \
            if (r_ < 896) { conv_matrix(args.in[3], D, MIXIN, (bf16_t*)(ws + WS_WIN0), args.in[1], 4, r_, scr, lane); continue; } r_ -= 896; \
            if (r_ < 200) { conv_matrix(args.in[12], SSMW, SSMW, (bf16_t*)(ws + WS_WGLU), nullptr, 0, r_, scr, lane); continue; } r_ -= 200; \
            if (r_ < 512) { conv_matrix(args.in[16], D, D, (bf16_t*)(ws + WS_WOUT0), nullptr, 0, r_, scr, lane); continue; } r_ -= 512; \
            if (r_ < 1536) { conv_matrix(args.in[17], D, CONVN, (bf16_t*)(ws + WS_WINC), args.in[1] + D, 3, r_, scr, lane); continue; } r_ -= 1536; \
            conv_matrix(args.in[19], D, D, (bf16_t*)(ws + WS_WOUTC), nullptr, 0, r_, scr, lane); } } while (0)
        static_assert(I_IN0 == 896 && I_GLU == 200 && I_O0 == 512 && I_INC == 1536 && I_OC == 512, "dense item list");
        DENSE_ITEMS(gw, NGW, 0, 896);
        (void)NITEMS;
        EXPERT_ITEMS(gw, NGW, 0, NE * I_EXP - FILL_IN - FILL_GLU);
        { u32x4* z = (u32x4*)((bf16_t*)(ws + WS_WGLU) + (size_t)SSMW * SSMW); const int n16 = (GLUN - SSMW) * SSMW * 2 / 16;
          for (int i = bx * 512 + tid; i < n16; i += G * 512) z[i] = (u32x4){0u, 0u, 0u, 0u}; }
        { bf16_t* wrt = (bf16_t*)(ws + WS_WRT);
          for (int i = bx * 512 + tid; i < 2 * 48 * D; i += G * 512) { const int layer = i / (48 * D), n = (i / D) % 48, k = i % D;
              float v = 0.f;
              if (n < 4) v = args.in[20][((size_t)layer * D + k) * 4 + n]; else if (n < 36) v = args.in[22][((size_t)layer * D + k) * NE + (n - 4)];
              v *= args.in[2][layer * D + k];
              const unsigned hi = f2bf(v); const float rem = v - __uint_as_float(hi << 16);
              wrt[(size_t)layer * 2 * 48 * D + (size_t)n * D + k] = (bf16_t)hi; wrt[(size_t)layer * 2 * 48 * D + 48 * D + (size_t)n * D + k] = (bf16_t)f2bf(rem); } }
        {
            const float* a_re = args.in[4]; const float* a_im = args.in[5]; const float* b_re = args.in[6]; const float* b_im = args.in[7];
            const float* c_re = args.in[8]; const float* c_im = args.in[9]; const float* logstep = args.in[11];
            float* Lam = (float*)(ws + WS_LAM); bf16_t* Kf = (bf16_t*)(ws + WS_KF); bf16_t* Ct = (bf16_t*)(ws + WS_CT); bf16_t* Bend = (bf16_t*)(ws + WS_BEND);
            for (int i = bx * 512 + tid; i < NG * 64 * NS; i += G * 512) { const int g = i / (64 * NS), t = (i / NS) % 64, p = i % NS;
                float wr_, wi_; cpow(a_re[g * NS + p], a_im[g * NS + p], expf(logstep[g]), (float)(t + 1), wr_, wi_);
                const int rt = t >> 4, row = t & 15, kc = p >> 4, kq = (p >> 2) & 3, half = (p >> 1) & 1, q = p & 1;
                float* o = Lam + ((((size_t)(g * 4 + rt) * 4 + kc) * 2 + half) * 64 + kq * 16 + row) * 4 + 2 * q; o[0] = wr_; o[1] = wi_; }
            for (int i = bx * 512 + tid; i < NG * NS * 64; i += G * 512) { const int g = i / (NS * 64), p = (i / 64) % NS, j = i % 64;
                const float lre = a_re[g * NS + p], lim = a_im[g * NS + p], step = expf(logstep[g]);
                float l1r, l1i; cpow(lre, lim, step, 1.f, l1r, l1i);
                const float nr = l1r - 1.f, ni = l1i, den = lre * lre + lim * lim, fr_ = (nr * lre + ni * lim) / den, fi_ = (ni * lre - nr * lim) / den;
                float wr_, wi_; cpow(lre, lim, step, (float)(63 - j), wr_, wi_);
                const float gr = wr_ * fr_ - wi_ * fi_, gi = wr_ * fi_ + wi_ * fr_;
                unsigned zr[8], zi[8];
#pragma unroll
                for (int h2 = 0; h2 < 8; ++h2) { float re[2], im[2];
#pragma unroll
                    for (int q = 0; q < 2; ++q) { const float xr = b_re[((size_t)g * NS + p) * GS + 2 * h2 + q], xi = b_im[((size_t)g * NS + p) * GS + 2 * h2 + q]; re[q] = gr * xr - gi * xi; im[q] = gr * xi + gi * xr; }
                    zr[h2] = pk2(re[0], re[1]); zi[h2] = pk2(im[0], im[1]); }
                u32x4* o0 = (u32x4*)(Bend + ((size_t)g * 128 + 2 * p) * 1024 + j * 16); u32x4* o1 = (u32x4*)(Bend + ((size_t)g * 128 + 2 * p + 1) * 1024 + j * 16);
                o0[0] = (u32x4){zr[0], zr[1], zr[2], zr[3]}; o0[1] = (u32x4){zr[4], zr[5], zr[6], zr[7]};
                o1[0] = (u32x4){zi[0], zi[1], zi[2], zi[3]}; o1[1] = (u32x4){zi[4], zi[5], zi[6], zi[7]}; }
            for (int i = bx * 512 + tid; i < NG * GS * NS; i += G * 512) { const int g = i / (GS * NS), h = (i / NS) % GS, p = i % NS;
                const int k = 2 * p, kc = k >> 5, kq = (k >> 3) & 3, j = k & 7;
                *(unsigned*)(Ct + (((size_t)g * 4 + kc) * 64 + kq * 16 + h) * 8 + j) = pk2(c_re[i], -c_im[i]); }
            {
                LAS float* cL = (LAS float*)lds;
                LAS float* bL = cL + 2048;
                LAS float* fw = bL + 2048 + wave * 128;
                int gl = -1;
                for (int task = bx; task < NG * 8; task += G) { const int g = task >> 3, tau = (task & 7) * 8 + wave;
                    if (g != gl) { gl = g; __syncthreads();
                        for (int i = tid; i < GS * NS; i += 512) { cL[2 * i] = c_re[(size_t)g * GS * NS + i]; cL[2 * i + 1] = c_im[(size_t)g * GS * NS + i]; bL[2 * i] = b_re[(size_t)g * NS * GS + i]; bL[2 * i + 1] = b_im[(size_t)g * NS * GS + i]; }
                        __syncthreads(); }
                    { const int p = lane; const float lre = a_re[g * NS + p], lim = a_im[g * NS + p], step = expf(logstep[g]);
                      float l1r, l1i; cpow(lre, lim, step, 1.f, l1r, l1i);
                      const float nr = l1r - 1.f, ni = l1i, den = lre * lre + lim * lim, fr_ = (nr * lre + ni * lim) / den, fi_ = (ni * lre - nr * lim) / den;
                      float wr_, wi_; cpow(lre, lim, step, (float)tau, wr_, wi_);
                      fw[2 * p] = wr_ * fr_ - wi_ * fi_; fw[2 * p + 1] = wr_ * fi_ + wi_ * fr_; }
                    asm volatile("s_waitcnt lgkmcnt(0)" ::: "memory"); __builtin_amdgcn_wave_barrier();
                    const int h = lane >> 2, hq = (lane & 3) * 4; float acc4[4] = {0.f, 0.f, 0.f, 0.f};
#pragma unroll 4
                    for (int p = 0; p < NS; ++p) { const float fr_ = fw[2 * p], fi_ = fw[2 * p + 1];
                        const float cr = cL[2 * (h * NS + p)], ci = cL[2 * (h * NS + p) + 1];
                        const float er = cr * fr_ - ci * fi_, ei = cr * fi_ + ci * fr_;
#pragma unroll
                        for (int q = 0; q < 4; ++q) acc4[q] += er * bL[2 * (p * GS + hq + q)] - ei * bL[2 * (p * GS + hq + q) + 1]; }
                    { const int ks = tau >> 1, kq2 = 2 * (tau & 1) + (hq >> 3), j = hq & 7;
                      *(u32x2*)(Kf + (((size_t)g * 32 + ks) * 64 + kq2 * 16 + h) * 8 + j) = (u32x2){pk2(acc4[0], acc4[1]), pk2(acc4[2], acc4[3])}; }
                    asm volatile("s_waitcnt lgkmcnt(0)" ::: "memory"); __builtin_amdgcn_wave_barrier();
                }
            }
        }
        for (int m = gw; m < T; m += NGW) {
            const f32x4* xr = (const f32x4*)(x + (size_t)m * D) + lane; f32x4 v[4]; float s = 0.f;
#pragma unroll
            for (int j = 0; j < 4; ++j) { v[j] = xr[64 * j]; s += (v[j].x * v[j].x + v[j].y * v[j].y) + (v[j].z * v[j].z + v[j].w * v[j].w); }
            s = wave_sum(s);
            if (lane == 0) rs_mix[m] = rsqrtf(s * (1.f / D) + EPS);
            u32x2* o8 = (u32x2*)(hb + (size_t)m * D) + lane;
#pragma unroll
            for (int j = 0; j < 4; ++j) o8[64 * j] = (u32x2){cvt_pk_bf16(v[j].x, v[j].y), cvt_pk_bf16(v[j].z, v[j].w)};
        }
        SEAM(PH_PRO);
    }

    if (IN(PH_INPROJ)) { PH_ENTER
        SchedPlain Sd{T / BM, MIXIN / BM, G, bx, D, (const char*)(ws + WS_WIN0)};
        EpiProj E{proj, (bf16_t*)(ws + WS_UG), rs_mix, args.in[14], args.in[15]};
        gemm_phase<EpiProj, SchedPlain, true, true>(lds, tid, (const char*)hb, D, Sd, E);
        { constexpr int I_EXP = 768; LAS float* scr = (LAS float*)(lds + wave * 16384); const int r = ((T / BM) * (MIXIN / BM)) % G;
          __syncthreads();
          if (r == 0) { DENSE_ITEMS(gw, NGW, 896, 1096); EXPERT_ITEMS(gw, NGW, NE * I_EXP - FILL_IN - FILL_GLU, NE * I_EXP - FILL_GLU); }
          else if (bx >= r) { DENSE_ITEMS((bx - r) * 8 + wave, (G - r) * 8, 896, 1096); EXPERT_ITEMS((bx - r) * 8 + wave, (G - r) * 8, NE * I_EXP - FILL_IN - FILL_GLU, NE * I_EXP - FILL_GLU); } }
        SEAM(PH_INPROJ);
    }

    if (IN(PH_ATTN)) { PH_ENTER
        const bool split_sa = G >= 4 * NG;
        if (!DRY_MASK || args.dry != 3) {
            SchedSsm Sd{split_sa ? G : NG, bx, (const char*)(ws + WS_BEND)};
            EpiSend E{(float*)(ws + WS_SEND)};
            gemm_phase<EpiSend, SchedSsm, true, true>(lds, tid, (const char*)(ws + WS_UG), 1024, Sd, E);
        }
        if (!DRY_MASK || args.dry != 2) {
            bf16_t* opart = (bf16_t*)(ws + WS_OPART); float* mpart = (float*)(ws + WS_MPART); float* lpart = (float*)(ws + WS_LPART);
            constexpr int KST = 144, VST = 192, VOFF = 384 * KST;
            const int r32 = lane & 31, hh = lane >> 5;
            u32x4 pk[6], pv[6];
#define ATT_DECODE(unit_) const int pat = (unit_) / 384, rem = (unit_) % 384, bh = rem % 12, b = bh / AH, h = bh % AH, rq = rem / 12; \
                const int dil = pat == 0 ? 1 : (pat == 1 ? 4 : 16), nqb = 32 / dil, res = rq / nqb, qb = rq % nqb; \
                const bf16_t* base = proj + (size_t)(b * S + res) * MIXIN + h * HD; const size_t tstride = (size_t)dil * MIXIN; const int i0 = 256 * qb - 128;
#define ATT_LOAD(unit_) do { ATT_DECODE(unit_) (void)h; \
                _Pragma("unroll") for (int j = 0; j < 6; ++j) { const int ch = tid + 512 * j, rho = ch >> 3, c16 = ch & 7, i = i0 + rho; const bf16_t* rp = base + (size_t)(i < 0 ? 0 : i) * tstride + SSMW + AW + c16 * 8; \
                    pk[j] = *(const u32x4*)rp; pv[j] = *(const u32x4*)(rp + AW); } } while (0)
            const int GA = split_sa ? G - NG : G, NU5 = (split_sa && 5 * GA < 3 * 384) ? 5 * GA : 3 * 384;
            const int u_first = bx < GA ? bx : NU5 + (bx - GA), u_step = bx < GA ? GA : NG, u_end = bx < GA ? NU5 : 3 * 384;
            if (u_first < u_end) ATT_LOAD(u_first);
            for (int unit = u_first; unit < u_end; unit += u_step) {
                ATT_DECODE(unit)
                __syncthreads();
                { int tl = tid; asm volatile("" : "+v"(tl));
#pragma unroll
                for (int j = 0; j < 6; ++j) { const int ch = tl + 512 * j, rho = ch >> 3, c16 = ch & 7;
                    *(LAS u32x4*)(lds + rho * KST + c16 * 16) = pk[j]; *(LAS u32x4*)(lds + VOFF + rho * VST + c16 * 16) = pv[j]; } }
                __syncthreads();
                const float slope2 = exp2f(-8.0f * (h + 1) / AH) * (float)dil * 1.4426950408889634f;
                const int iq = 256 * qb + 32 * wave + r32;
                bf16x8 qf[4];
#pragma unroll
                for (int s = 0; s < 4; ++s) qf[s] = *(const bf16x8*)(base + (size_t)iq * tstride + SSMW + 16 * s + 8 * hh);
                f32x16 sc[5];
                const LAS unsigned char* kb = lds + (32 * wave + r32) * KST + hh * 16;
#pragma unroll
                for (int kt = 0; kt < 5; ++kt) {
                    f32x16 a = (f32x16){0.f, 0.f, 0.f, 0.f, 0.f, 0.f, 0.f, 0.f, 0.f, 0.f, 0.f, 0.f, 0.f, 0.f, 0.f, 0.f};
#pragma unroll
                    for (int s = 0; s < 4; ++s) a = mfma32(*(const LAS bf16x8*)(kb + kt * 32 * KST + s * 32), qf[s], a);
                    sc[kt] = a;
                }
                if (unit + u_step < u_end) ATT_LOAD(unit + u_step);
                float loff = (float)(r32 - 4 * hh); asm volatile("" : "+v"(loff));
                const float dhalf = 0.5f * (float)(iq < 128 ? iq : 128);
                float mx = -INFINITY;
#pragma unroll
                for (int kt = 0; kt < 5; ++kt)
#pragma unroll
                    for (int r = 0; r < 16; ++r) { const float diff = loff + (float)(128 - 32 * kt - ((r & 3) + 8 * (r >> 2)));
                        float v = sc[kt][r] - slope2 * diff;
                        if (kt == 0 || kt == 4 || qb == 0) v = (fabsf(diff - dhalf) <= dhalf) ? v : -INFINITY;
                        sc[kt][r] = v; mx = fmaxf(mx, v); }
                mx = fmaxf(mx, __shfl_xor(mx, 32));
                float l = 0.f;
#pragma unroll
                for (int kt = 0; kt < 5; ++kt)
#pragma unroll
                    for (int r = 0; r < 16; ++r) { const float e = __builtin_amdgcn_exp2f(sc[kt][r] - mx); sc[kt][r] = e; l += e; }
                l += __shfl_xor(l, 32);
                f32x16 o[2];
#pragma unroll
                for (int dt = 0; dt < 2; ++dt) o[dt] = (f32x16){0.f, 0.f, 0.f, 0.f, 0.f, 0.f, 0.f, 0.f, 0.f, 0.f, 0.f, 0.f, 0.f, 0.f, 0.f, 0.f};
                const int G4 = lane >> 4, q4 = (lane & 15) >> 2, p4 = lane & 3;
                LAS unsigned char* vb = lds + VOFF + (32 * wave + 4 * (G4 >> 1) + q4) * VST + (16 * (G4 & 1) + 4 * p4) * 2;
#pragma unroll
                for (int kt = 0; kt < 5; ++kt)
#pragma unroll
                    for (int s2 = 0; s2 < 2; ++s2) {
                        const bf16x8 pfv = __builtin_bit_cast(bf16x8, (u32x4){cvt_pk_bf16(sc[kt][8 * s2 + 0], sc[kt][8 * s2 + 1]), cvt_pk_bf16(sc[kt][8 * s2 + 2], sc[kt][8 * s2 + 3]),
                                                                               cvt_pk_bf16(sc[kt][8 * s2 + 4], sc[kt][8 * s2 + 5]), cvt_pk_bf16(sc[kt][8 * s2 + 6], sc[kt][8 * s2 + 7])});
#pragma unroll
                        for (int dt = 0; dt < 2; ++dt) {
                            const s16x4 lo4 = vtr(vb + (kt * 32 + s2 * 16) * VST + dt * 64), hi4 = vtr(vb + (kt * 32 + s2 * 16 + 8) * VST + dt * 64);
                            const bf16x8 vf = (bf16x8){lo4[0], lo4[1], lo4[2], lo4[3], hi4[0], hi4[1], hi4[2], hi4[3]};
                            o[dt] = mfma32(vf, pfv, o[dt]); }
                    }
                const float rl = 1.f / l;
                const size_t tok = (size_t)(b * S + res) + (size_t)iq * dil;
                bf16_t* op = opart + ((size_t)pat * T + tok) * AW + h * HD;
#pragma unroll
                for (int dt = 0; dt < 2; ++dt)
#pragma unroll
                    for (int r4 = 0; r4 < 4; ++r4) *(u32x2*)(op + 32 * dt + 8 * r4 + 4 * hh) = (u32x2){cvt_pk_bf16(o[dt][4 * r4] * rl, o[dt][4 * r4 + 1] * rl), cvt_pk_bf16(o[dt][4 * r4 + 2] * rl, o[dt][4 * r4 + 3] * rl)};
                if (hh == 0) { mpart[((size_t)pat * T + tok) * AH + h] = mx; lpart[((size_t)pat * T + tok) * AH + h] = l; }
            }
            __syncthreads();
#undef ATT_DECODE
#undef ATT_LOAD
        }
#if DBG == 2
        {
            bf16_t* dbg = (bf16_t*)(ws + WS_DBGA);
            LAS float* scn = (LAS float*)(lds + 65536 + wave * 2048);
            for (int gi = gw; gi < T * AH; gi += NGW) {
                const int tg = gi / AH, h = gi % AH, b = tg / S, t = tg % S;
                const float slope = exp2f(-8.0f * (h + 1) / AH);
                const float q = bf2f(proj[(size_t)tg * MIXIN + SSMW + h * HD + lane]);
                const bf16_t* Kb = proj + (size_t)b * S * MIXIN + SSMW + AW + h * HD;
                const bf16_t* Vb = proj + (size_t)b * S * MIXIN + SSMW + 2 * AW + h * HD;
                for (int idx = 0; idx < 387; ++idx) { const int pp = idx / 129, j = idx % 129, dil = pp == 0 ? 1 : (pp == 1 ? 4 : 16), tk = t - j * dil;
                    float s = -INFINITY;
                    if (tk >= 0) s = wave_sum(q * bf2f(Kb[(size_t)tk * MIXIN + lane])) - slope * 1.4426950408889634f * (float)(j * dil);
                    if (lane == 0) scn[idx] = s; }
                asm volatile("s_waitcnt lgkmcnt(0)" ::: "memory"); __builtin_amdgcn_wave_barrier();
                float m = -INFINITY;
                for (int idx = lane; idx < 387; idx += 64) m = fmaxf(m, scn[idx]);
                m = wave_max(m);
                float l = 0.f;
                for (int idx = lane; idx < 387; idx += 64) { const float s = scn[idx]; const float e = (s == -INFINITY) ? 0.f : exp2f(s - m); scn[idx] = e; l += e; }
                l = wave_sum(l);
                asm volatile("s_waitcnt lgkmcnt(0)" ::: "memory"); __builtin_amdgcn_wave_barrier();
                float o = 0.f;
                for (int idx = 0; idx < 387; ++idx) { const int pp = idx / 129, j = idx % 129, dil = pp == 0 ? 1 : (pp == 1 ? 4 : 16), tk = t - j * dil;
                    if (tk >= 0) o += scn[idx] * bf2f(Vb[(size_t)tk * MIXIN + lane]); }
                dbg[(size_t)tg * AW + h * HD + lane] = (bf16_t)f2bf(o / l);
                asm volatile("s_waitcnt lgkmcnt(0)" ::: "memory"); __builtin_amdgcn_wave_barrier();
            }
        }
#endif
        SEAM(PH_ATTN);
    }


    if (IN(PH_SSMY)) { PH_ENTER
        const bf16_t* Kf = (const bf16_t*)(ws + WS_KF); const bf16_t* Ct = (const bf16_t*)(ws + WS_CT); const float* Lam = (const float*)(ws + WS_LAM);
        const float* send = (const float*)(ws + WS_SEND); const float* dsk = args.in[10];
        const int row = lane & 15, kq = lane >> 4;
        LAS float* sinL = (LAS float*)(lds + 102400);
        float csr = 0.f, csi = 0.f, cwr = 0.f, cwi = 0.f; int sc_gb = -1, sc_c = 0;
        LAS unsigned char* Uw = lds + 69632 + wave * 4096;
        *(LAS u32x4*)(Uw + lane * 32) = (u32x4){0u, 0u, 0u, 0u}; *(LAS u32x4*)(Uw + lane * 32 + 16) = (u32x4){0u, 0u, 0u, 0u};
        int gcur = -1;
        const int NU = NB * NG * 16, per = (NU + G - 1) / G;
        const int u_end = (bx + 1) * per < NU ? (bx + 1) * per : NU;
        u32x4 nv0, nv1;
#define SSM_LOAD(u_) do { const int g_ = (u_) / 32, b_ = ((u_) >> 4) & 1, c_ = ((u_) & 15) * 8 + wave; \
            const bf16_t* up_ = (const bf16_t*)(ws + WS_UG) + ((size_t)(g_ * NB + b_) * S + c_ * 64) * GS + lane * 8; nv0 = *(const u32x4*)up_; nv1 = *(const u32x4*)(up_ + 512); } while (0)
        if (bx * per < u_end) SSM_LOAD(bx * per);
        for (int u = bx * per; u < u_end; ++u) { const int g = u / 32, b = (u >> 4) & 1, cb = u & 15;
            if (g != gcur) { gcur = g; __syncthreads();
                const u32x4* s0 = (const u32x4*)(Kf + (size_t)g * 32 * 64 * 8); const u32x4* s1 = (const u32x4*)(Ct + (size_t)g * 4 * 64 * 8); const u32x4* s2 = (const u32x4*)(Lam + (size_t)g * 4 * 4 * 2 * 64 * 4);
                for (int i = tid; i < 2048; i += 512) *(LAS u32x4*)(lds + i * 16) = s0[i];
                if (tid < 256) *(LAS u32x4*)(lds + 32768 + tid * 16) = s1[tid];
                for (int i = tid; i < 2048; i += 512) *(LAS u32x4*)(lds + 36864 + i * 16) = s2[i];
                __syncthreads(); }
            const int c = cb * 8 + wave, t0 = b * S + c * 64;
            *(LAS u32x4*)(Uw + 2048 + lane * 16) = nv0; *(LAS u32x4*)(Uw + 2048 + 1024 + lane * 16) = nv1;
            if (u + 1 < u_end) SSM_LOAD(u + 1);
            LAS float* sL = sinL + ((u & 1) ? 1024 : 0);
            if (wave == 0) {
                if (g * NB + b != sc_gb) { sc_gb = g * NB + b; sc_c = 0; csr = 0.f; csi = 0.f; cpow(args.in[4][g * NS + lane], args.in[5][g * NS + lane], expf(args.in[11][g]), 64.f, cwr, cwi); }
                const float* sp = send + ((size_t)(b * NG + g) * 128) * 128 + 2 * lane;
                for (; sc_c < 8 * cb; sc_c += 8) { float2 e[8];
#pragma unroll
                    for (int j = 0; j < 8; ++j) e[j] = *(const float2*)(sp + (size_t)(sc_c + j) * 128);
#pragma unroll
                    for (int j = 0; j < 8; ++j) { const float nr = cwr * csr - cwi * csi + e[j].x, ni = cwr * csi + cwi * csr + e[j].y; csr = nr; csi = ni; } }
                { float2 e[8];
#pragma unroll
                  for (int j = 0; j < 8; ++j) e[j] = *(const float2*)(sp + (size_t)(8 * cb + j) * 128);
#pragma unroll
                  for (int j = 0; j < 8; ++j) { sL[j * 128 + 2 * lane] = csr; sL[j * 128 + 2 * lane + 1] = csi;
                      const float nr = cwr * csr - cwi * csi + e[j].x, ni = cwr * csi + cwi * csr + e[j].y; csr = nr; csi = ni; }
                  sc_c = 8 * cb + 8; }
            }
            __syncthreads();
            f32x4 sv[4][2];
#pragma unroll
            for (int kc = 0; kc < 4; ++kc) { sv[kc][0] = *(const LAS f32x4*)(sL + wave * 128 + 32 * kc + 8 * kq); sv[kc][1] = *(const LAS f32x4*)(sL + wave * 128 + 32 * kc + 8 * kq + 4); }
            asm volatile("s_waitcnt lgkmcnt(0)" ::: "memory"); __builtin_amdgcn_wave_barrier();
            f32x4 acc[4];
#pragma unroll
            for (int rt = 0; rt < 4; ++rt) acc[rt] = (f32x4){0.f, 0.f, 0.f, 0.f};
            const LAS unsigned char* ua = Uw + (64 + row - (kq >> 1)) * 32 + (kq & 1) * 16;
#pragma unroll
            for (int kb = 0; kb < 4; ++kb)
#pragma unroll
                for (int k8 = 0; k8 < 8; ++k8) { const int ks = 8 * kb + k8;
                    const bf16x8 bfr = *(const LAS bf16x8*)(lds + (ks * 64 + lane) * 16);
#pragma unroll
                    for (int rt = kb; rt < 4; ++rt) acc[rt] = mfma16(*(const LAS bf16x8*)(ua + (16 * rt - 2 * ks) * 32), bfr, acc[rt]); }
#pragma unroll
            for (int kc = 0; kc < 4; ++kc) { const bf16x8 bfr = *(const LAS bf16x8*)(lds + 32768 + (kc * 64 + lane) * 16);
#pragma unroll
                for (int rt = 0; rt < 4; ++rt) { const LAS unsigned char* lp = lds + 36864 + ((rt * 4 + kc) * 2 * 64 + lane) * 16;
                    const f32x4 l01 = *(const LAS f32x4*)lp, l23 = *(const LAS f32x4*)(lp + 1024); const f32x4 s01 = sv[kc][0], s23 = sv[kc][1];
                    const bf16x8 afv = __builtin_bit_cast(bf16x8, (u32x4){
                        cvt_pk_bf16(l01[0] * s01[0] - l01[1] * s01[1], l01[0] * s01[1] + l01[1] * s01[0]), cvt_pk_bf16(l01[2] * s01[2] - l01[3] * s01[3], l01[2] * s01[3] + l01[3] * s01[2]),
                        cvt_pk_bf16(l23[0] * s23[0] - l23[1] * s23[1], l23[0] * s23[1] + l23[1] * s23[0]), cvt_pk_bf16(l23[2] * s23[2] - l23[3] * s23[3], l23[2] * s23[3] + l23[3] * s23[2])});
                    acc[rt] = mfma16(afv, bfr, acc[rt]); } }
            const float dk = dsk[g * GS + row];
#pragma unroll
            for (int rt = 0; rt < 4; ++rt)
#pragma unroll
                for (int r = 0; r < 4; ++r) { const int tl = 16 * rt + 4 * kq + r, t = t0 + tl;
                    const float uu = bf2f(*(const LAS bf16_t*)(Uw + 2048 + tl * 32 + row * 2));
#if DBG == 1
                    ((bf16_t*)(ws + WS_DBGA))[(size_t)t * SSMW + g * GS + row] = (bf16_t)f2bf(acc[rt][r] * 64.f);
#endif
                    yssm[(size_t)t * SSMW + g * GS + row] = (bf16_t)f2bf(gelu_tanh(acc[rt][r] + dk * uu)); }
            asm volatile("s_waitcnt lgkmcnt(0)" ::: "memory"); __builtin_amdgcn_wave_barrier();
        }
        {
            const bf16_t* opart = (const bf16_t*)(ws + WS_OPART); const float* mpart = (const float*)(ws + WS_MPART); const float* lpart = (const float*)(ws + WS_LPART);
            for (int i = bx * 512 + tid; i < T * AH * 8; i += G * 512) { const int th = i >> 3, c8 = (i & 7) * 8, t = th / AH, h = th % AH;
                float m[3], l[3]; u32x4 o[3];
#pragma unroll
                for (int pp = 0; pp < 3; ++pp) { m[pp] = mpart[((size_t)pp * T + t) * AH + h]; l[pp] = lpart[((size_t)pp * T + t) * AH + h]; o[pp] = *(const u32x4*)(opart + ((size_t)pp * T + t) * AW + h * HD + c8); }
                const float M = fmaxf(m[0], fmaxf(m[1], m[2]));
                float w0 = l[0] * exp2f(m[0] - M), w1 = l[1] * exp2f(m[1] - M), w2 = l[2] * exp2f(m[2] - M);
                const float rw = 1.f / (w0 + w1 + w2); w0 *= rw; w1 *= rw; w2 *= rw;
                f32x4 a0, a1, b0, b1, c0, c1; unpack8(o[0], a0, a1); unpack8(o[1], b0, b1); unpack8(o[2], c0, c1);
                *(u32x4*)(concat + (size_t)t * D + SSMW + h * HD + c8) = pack8(a0 * w0 + b0 * w1 + c0 * w2, a1 * w0 + b1 * w1 + c1 * w2);
            }
        }
        { constexpr int I_EXP = 768; LAS float* scr = (LAS float*)(lds + wave * 16384);
          __syncthreads();
          EXPERT_ITEMS(gw, NGW, NE * I_EXP + FILL_G1 + FILL_G2, 2 * NE * I_EXP); }
#if DBG == 1
        if (wave == 0 && bx < NB * NG) {
            const int b = bx / NG, g = bx % NG, p = lane;
            const float* a_re = args.in[4]; const float* a_im = args.in[5]; const float* b_re = args.in[6]; const float* b_im = args.in[7];
            const float* c_re = args.in[8]; const float* c_im = args.in[9]; const float* logstep = args.in[11];
            const float lre = a_re[g * NS + p], lim = a_im[g * NS + p], step = expf(logstep[g]);
            const float er = expf(lre * step), lbr = er * cosf(lim * step), lbi = er * sinf(lim * step);
            const float nr = lbr - 1.f, ni = lbi, den = lre * lre + lim * lim;
            const float fr_ = (nr * lre + ni * lim) / den, fi_ = (ni * lre - nr * lim) / den;
            float bbr[GS], bbi[GS], cr[GS], ci[GS];
#pragma unroll
            for (int h = 0; h < GS; ++h) {
                const float xr = b_re[((size_t)g * NS + p) * GS + h], xi = b_im[((size_t)g * NS + p) * GS + h];
                bbr[h] = fr_ * xr - fi_ * xi; bbi[h] = fr_ * xi + fi_ * xr;
                cr[h] = c_re[((size_t)g * GS + h) * NS + p]; ci[h] = c_im[((size_t)g * GS + h) * NS + p];
            }
            float sr = 0.f, si = 0.f;
            for (int t = 0; t < S; ++t) {
                const u32x4* up = (const u32x4*)((const bf16_t*)(ws + WS_UG) + ((size_t)(g * NB + b) * S + t) * GS);
                f32x4 u0, u1, u2, u3; unpack8(up[0], u0, u1); unpack8(up[1], u2, u3);
                const float u[GS] = {u0[0], u0[1], u0[2], u0[3], u1[0], u1[1], u1[2], u1[3], u2[0], u2[1], u2[2], u2[3], u3[0], u3[1], u3[2], u3[3]};
                float br = 0.f, bi = 0.f;
#pragma unroll
                for (int h = 0; h < GS; ++h) { br += bbr[h] * u[h]; bi += bbi[h] * u[h]; }
                const float nsr = lbr * sr - lbi * si + br, nsi = lbr * si + lbi * sr + bi;
                sr = nsr; si = nsi;
                float mine = 0.f;
#pragma unroll
                for (int h = 0; h < GS; ++h) { const float v = wave_sum(cr[h] * sr - ci[h] * si); if (p == h) mine = v; }
                if (p < GS) ((bf16_t*)(ws + WS_DBGB))[(size_t)(b * S + t) * SSMW + g * GS + p] = (bf16_t)f2bf(mine * 64.f);
            }
        }
#endif
        SEAM(PH_SSMY);
    }

    if (IN(PH_GLU)) { PH_ENTER
#if DBG
        {
            const bf16_t* A = (const bf16_t*)(ws + WS_DBGA); const bf16_t* B = (const bf16_t*)(ws + WS_DBGB);
            float* acc = (float*)(ctl + CW_DBG);
            const size_t n = (DBG == 1) ? (size_t)T * SSMW : (size_t)T * AW;
            float num = 0.f, den = 0.f;
            if (DBG == 1) { for (size_t i = (size_t)bx * 512 + tid; i < n; i += (size_t)G * 512) { const float a = bf2f(A[i]), b = bf2f(B[i]); num += (a - b) * (a - b); den += b * b; } }
            else { for (size_t i = (size_t)bx * 512 + tid; i < n; i += (size_t)G * 512) { const size_t t = i / AW, c = i % AW; const float a = bf2f(A[i]), b = bf2f(concat[t * D + SSMW + c]); num += (a - b) * (a - b); den += a * a; } }
            num = wave_sum(num); den = wave_sum(den);
            if (lane == 0) { atomicAdd(acc, num); atomicAdd(acc + 1, den); }
        }
#endif
        SchedPlain Sd{T / BM, GLUN / BM, G, bx, SSMW, (const char*)(ws + WS_WGLU)};
        EpiGlu E{yssm, concat, args.in[13]};
        gemm_phase<EpiGlu, SchedPlain, true, true>(lds, tid, (const char*)yssm, SSMW, Sd, E);
        { constexpr int I_EXP = 768; LAS float* scr = (LAS float*)(lds + wave * 16384); const int nu = (T / BM) * (GLUN / BM);
          __syncthreads();
          if (nu >= G) { DENSE_ITEMS(gw, NGW, 1096, 1608); EXPERT_ITEMS(gw, NGW, NE * I_EXP - FILL_GLU, NE * I_EXP); }
          else if (bx >= nu) { DENSE_ITEMS((bx - nu) * 8 + wave, (G - nu) * 8, 1096, 1608); EXPERT_ITEMS((bx - nu) * 8 + wave, (G - nu) * 8, NE * I_EXP - FILL_GLU, NE * I_EXP); } }
        SEAM(PH_GLU);
    }

    if (IN(PH_OUT0)) { PH_ENTER
        SchedPlain Sd{T / BM, D / BM, G, bx, D, (const char*)(ws + WS_WOUT0)};
        EpiResid E{hb};
        gemm_phase<EpiResid, SchedPlain, true, true>(lds, tid, (const char*)concat, D, Sd, E);
        SEAM(PH_OUT0);
    }

    for (int layer = 0; layer < 2; ++layer) {
        const int pb = (layer == 0) ? PH_RT0 : PH_RT1;
        if (IN(pb)) { PH_ENTER
            int* cnt = (int*)(ctl + CW_CNT) + layer * 4096;
#if DRY_MASK
            if (args.dry) { cnt += 8192; list = (int*)(ws + 256 * MiB); gatel = (float*)(ws + 260 * MiB); tokrow = (int*)(ws + 264 * MiB); rs_ffn = (float*)(ws + 266 * MiB); }
#endif
            const float* brg = args.in[21] + layer * 4; const float* bre = args.in[23] + layer * NE;
            const bf16_t* wrt = (const bf16_t*)(ws + WS_WRT) + (size_t)layer * 2 * 48 * D;
            LAS float* L = (LAS float*)(lds + wave * 12544);
            const int row = lane & 15, kq = lane >> 4;
            for (int task = bx; task < T / 64; task += G) {
                const int t0 = task * 64;
                const bf16_t* bp = wrt + (size_t)row * D + 128 * wave + 8 * kq;
                bf16x8 bh[3][4], bl[3][4];
#pragma unroll
                for (int nt = 0; nt < 3; ++nt)
#pragma unroll
                    for (int ks = 0; ks < 4; ++ks) { bh[nt][ks] = *(const bf16x8*)(bp + (size_t)nt * 16 * D + 32 * ks); bl[nt][ks] = *(const bf16x8*)(bp + (size_t)(48 + nt * 16) * D + 32 * ks); }
#pragma unroll
                for (int rt = 0; rt < 4; ++rt) {
                    const bf16_t* ap = hb + (size_t)(t0 + 16 * rt + row) * D + 128 * wave + 8 * kq;
                    u32x4 a[4];
#pragma unroll
                    for (int ks = 0; ks < 4; ++ks) a[ks] = *(const u32x4*)(ap + 32 * ks);
                    f32x4 acc[3] = {(f32x4){0.f, 0.f, 0.f, 0.f}, (f32x4){0.f, 0.f, 0.f, 0.f}, (f32x4){0.f, 0.f, 0.f, 0.f}};
                    float ss = 0.f;
#pragma unroll
                    for (int ks = 0; ks < 4; ++ks) { f32x4 x0, x1; unpack8(a[ks], x0, x1);
                        ss += ((x0[0] * x0[0] + x0[1] * x0[1]) + (x0[2] * x0[2] + x0[3] * x0[3])) + ((x1[0] * x1[0] + x1[1] * x1[1]) + (x1[2] * x1[2] + x1[3] * x1[3]));
                        const bf16x8 af = __builtin_bit_cast(bf16x8, a[ks]);
#pragma unroll
                        for (int nt = 0; nt < 3; ++nt) { acc[nt] = mfma16(af, bh[nt][ks], acc[nt]); acc[nt] = mfma16(af, bl[nt][ks], acc[nt]); } }
                    ss += __shfl_xor(ss, 16); ss += __shfl_xor(ss, 32);
#pragma unroll
                    for (int nt = 0; nt < 3; ++nt)
#pragma unroll
                        for (int r = 0; r < 4; ++r) L[(16 * rt + 4 * kq + r) * 48 + nt * 16 + row] = acc[nt][r];
                    if (lane < 16) L[3072 + 16 * rt + lane] = ss;
                }
                __syncthreads();
                if (tid < 64) { const int t = t0 + tid;
                    float lg[36]; float sq = 0.f;
#pragma unroll
                    for (int j = 0; j < 36; ++j) lg[j] = 0.f;
#pragma unroll
                    for (int w = 0; w < 8; ++w) { const LAS float* Lw = (const LAS float*)(lds + w * 12544); sq += Lw[3072 + tid];
#pragma unroll
                        for (int j = 0; j < 36; ++j) lg[j] += Lw[tid * 48 + j]; }
                    const float r = rsqrtf(sq * (1.f / D) + EPS);
                    rs_ffn[t] = r;
                    LAS float* Lr = L + tid * 48;
#pragma unroll
                    for (int j = 0; j < 36; ++j) Lr[j] = lg[j];
                    float mg = -INFINITY; int gi = 0;
                    for (int j = 0; j < 4; ++j) { const float v = Lr[j] * r + brg[j]; if (v > mg) { mg = v; gi = j; } }
                    float sg = 0.f; for (int j = 0; j < 4; ++j) sg += expf(Lr[j] * r + brg[j] - mg);
                    const float gwt = 1.f / sg;
                    int i1 = 0; float m1 = -INFINITY;
                    for (int j = 0; j < 8; ++j) { const float v = Lr[4 + gi * 8 + j] * r + bre[gi * 8 + j]; if (v > m1) { m1 = v; i1 = j; } }
                    int i2 = 0; float m2 = -INFINITY;
                    for (int j = 0; j < 8; ++j) { const float v = Lr[4 + gi * 8 + j] * r + bre[gi * 8 + j]; if (j != i1 && v > m2) { m2 = v; i2 = j; } }
                    const float p2 = expf(m2 - m1);
                    const float g1 = gwt / (1.f + p2), g2 = gwt * p2 / (1.f + p2);
                    const int e1 = gi * 8 + i1, e2 = gi * 8 + i2;
                    LAS int* lc = (LAS int*)(lds + 8 * 12544); LAS int* lb = lc + 32;
                    if (tid < 32) lc[tid] = 0;
                    asm volatile("s_waitcnt lgkmcnt(0)" ::: "memory"); __builtin_amdgcn_wave_barrier();
                    const int q1 = __hip_atomic_fetch_add(&lc[e1], 1, __ATOMIC_RELAXED, __HIP_MEMORY_SCOPE_WORKGROUP);
                    const int q2 = __hip_atomic_fetch_add(&lc[e2], 1, __ATOMIC_RELAXED, __HIP_MEMORY_SCOPE_WORKGROUP);
                    asm volatile("s_waitcnt lgkmcnt(0)" ::: "memory"); __builtin_amdgcn_wave_barrier();
                    if (tid < 32) { const int n = lc[tid]; lb[tid] = n > 0 ? atomicAdd(&cnt[64 * tid], n) : 0; }
                    asm volatile("s_waitcnt vmcnt(0) lgkmcnt(0)" ::: "memory"); __builtin_amdgcn_wave_barrier();
                    const int s1 = lb[e1] + q1, s2 = lb[e2] + q2;
                    list[(size_t)e1 * CAP + s1] = t; gatel[(size_t)e1 * CAP + s1] = g1;
                    list[(size_t)e2 * CAP + s2] = t; gatel[(size_t)e2 * CAP + s2] = g2;
                    tokrow[t * 4 + 0] = e1; tokrow[t * 4 + 1] = s1; tokrow[t * 4 + 2] = e2; tokrow[t * 4 + 3] = s2;
                }
                __syncthreads();
            }
            SEAM(pb);
        }
        if (IN(pb + 1) || IN(pb + 2)) { PH_ENTER
            int* cnt = (int*)(ctl + CW_CNT) + layer * 4096;
            LAS int* tile_e = (LAS int*)(lds + TAB_TILE_E); LAS int* tile_m = (LAS int*)(lds + TAB_TILE_M); LAS int* ntp = (LAS int*)(lds + TAB_NT);
            LAS int* tokT = (LAS int*)(lds + TAB_TOK); LAS float* gateT = (LAS float*)(lds + TAB_GATE);
            __syncthreads();
            LAS int* cntL = (LAS int*)(lds + TAB_NT + 16);
            if (tid < 64) { const int e = lane & 31; const int c = __hip_atomic_load(&cnt[64 * e], __ATOMIC_RELAXED, __HIP_MEMORY_SCOPE_AGENT); const int mt = (c + 255) >> 8;
                int inc = mt;
#pragma unroll
                for (int o = 1; o < 32; o <<= 1) { const int v = __shfl_up(inc, o, 32); if (e >= o) inc += v; }
                if (tid < 32) { cntL[e] = c; const int st = inc - mt; for (int j = 0; j < mt; ++j) { tile_e[st + j] = e; tile_m[st + j] = j; } if (e == 31) *ntp = inc; } }
            __syncthreads();
            const int ntiles = *ntp;
            for (int i = 0; i < 4; ++i) { const int L = i * G + bx; if (L >= ntiles * 4) break;
                int pm, pn; unit_map(L, ntiles, 4, pm, pn); const int e = tile_e[pm], tm = tile_m[pm];
                const int c = cntL[e];
                if (tid < 256) { const int idx = tm * 256 + tid; const bool ok = idx < c;
                    tokT[i * 256 + tid] = ok ? list[(size_t)e * CAP + idx] : 0; gateT[i * 256 + tid] = ok ? gatel[(size_t)e * CAP + idx] : 0.f; } }
            __syncthreads();
            if (IN(pb + 1)) {
                SchedMoe Sd{ntiles, 4, G, bx, D, (const char*)(ws + WS_WGU + (size_t)layer * WS_MOE_LAYER), (size_t)D * D * 2, tile_e, tokT, tile_m, cntL};
                EpiMoe1 E{Hb, rs_ffn, tokT};
                gemm_phase<EpiMoe1, SchedMoe, true, true>(lds, tid, (const char*)hb, D, Sd, E);
                if (layer == 0) {
                    constexpr int I_EXP = 768; LAS float* scr = (LAS float*)(lds + wave * 16384); const int r = (ntiles * 4) % G;
                    __syncthreads();
                    if (r == 0) { DENSE_ITEMS(gw, NGW, 1608, 3656); EXPERT_ITEMS(gw, NGW, NE * I_EXP, NE * I_EXP + FILL_G1); }
                    else if (bx >= r) { DENSE_ITEMS((bx - r) * 8 + wave, (G - r) * 8, 1608, 3656); EXPERT_ITEMS((bx - r) * 8 + wave, (G - r) * 8, NE * I_EXP, NE * I_EXP + FILL_G1); } }
                SEAM(pb + 1);
            }
            if (IN(pb + 2)) {
                SchedMoe Sd{ntiles, 4, G, bx, DE, (const char*)(ws + WS_WD + (size_t)layer * WS_MOE_LAYER), (size_t)D * DE * 2, tile_e, nullptr, tile_m, cntL};
                EpiMoe2 E{Yb, gateT};
                gemm_phase<EpiMoe2, SchedMoe, true, true>(lds, tid, (const char*)Hb, DE, Sd, E);
                if (layer == 0) {
                    constexpr int I_EXP = 768; LAS float* scr = (LAS float*)(lds + wave * 16384); const int r = (ntiles * 4) % G;
                    __syncthreads();
                    if (r == 0) EXPERT_ITEMS(gw, NGW, NE * I_EXP + FILL_G1, NE * I_EXP + FILL_G1 + FILL_G2);
                    else if (bx >= r) EXPERT_ITEMS((bx - r) * 8 + wave, (G - r) * 8, NE * I_EXP + FILL_G1, NE * I_EXP + FILL_G1 + FILL_G2); }
                SEAM(pb + 2);
            }
        }
        if (IN(pb + 3)) { PH_ENTER
            int* cnt = (int*)(ctl + CW_CNT) + layer * 4096;
            __syncthreads();
            LAS int* pst = (LAS int*)(lds + TAB_TILE_E);
            if (tid < 64) { const int e = lane & 31; const int c = __hip_atomic_load(&cnt[64 * e], __ATOMIC_RELAXED, __HIP_MEMORY_SCOPE_AGENT); const int mt = (c + 255) >> 8;
                int inc = mt;
#pragma unroll
                for (int o = 1; o < 32; o <<= 1) { const int v = __shfl_up(inc, o, 32); if (e >= o) inc += v; }
                if (tid < 32) pst[e] = (inc - mt) << 8; }
            __syncthreads();
            int myr1 = 0, myr2 = 0;
            { const int t = gw + lane * NGW; if (t < T) { const int4 tr = *(const int4*)(tokrow + t * 4); myr1 = pst[tr.x] + tr.y; myr2 = pst[tr.z] + tr.w; } }
            for (int k = 0, t = gw; t < T; ++k, t += NGW) {
                const int r1 = __shfl(myr1, k), r2 = __shfl(myr2, k);
                u32x2* hr = (u32x2*)(hb + (size_t)t * D) + lane; const u32x2* y1 = (const u32x2*)(Yb + (size_t)r1 * D) + lane; const u32x2* y2 = (const u32x2*)(Yb + (size_t)r2 * D) + lane;
                float s = 0.f; f32x4 v[4];
#pragma unroll
                for (int j = 0; j < 4; ++j) { const u32x2 a = y1[64 * j], b = y2[64 * j], c = hr[64 * j]; f32x4 hv;
                    hv.x = bf_lo(c.x) + (bf_lo(a.x) + bf_lo(b.x)); hv.y = bf_hi(c.x) + (bf_hi(a.x) + bf_hi(b.x)); hv.z = bf_lo(c.y) + (bf_lo(a.y) + bf_lo(b.y)); hv.w = bf_hi(c.y) + (bf_hi(a.y) + bf_hi(b.y));
                    v[j] = hv; s += (hv.x * hv.x + hv.y * hv.y) + (hv.z * hv.z + hv.w * hv.w); }
                if (layer == 0) {
                    s = wave_sum(s);
                    if (lane == 0) rs_mix[t] = rsqrtf(s * (1.f / D) + EPS);
#pragma unroll
                    for (int j = 0; j < 4; ++j) hr[64 * j] = (u32x2){cvt_pk_bf16(v[j].x, v[j].y), cvt_pk_bf16(v[j].z, v[j].w)};
                } else {
                    f32x4* ho = (f32x4*)(hout + (size_t)t * D) + lane;
#pragma unroll
                    for (int j = 0; j < 4; ++j) ho[64 * j] = v[j]; }
            }
            if (layer == 0) SEAM(pb + 3);
        }
        if (layer == 0) {
            if (IN(PH_CONVIN)) { PH_ENTER
                SchedPlain Sd{T / BM, CONVN / BM, G, bx, D, (const char*)(ws + WS_WINC)};
                EpiConvIn E{bgate, zcb, rs_mix};
                gemm_phase<EpiConvIn, SchedPlain, true, true>(lds, tid, (const char*)hb, D, Sd, E);
                SEAM(PH_CONVIN);
            }
            if (IN(PH_CONV)) { PH_ENTER
                const float* cw = args.in[18];
                const int c8 = ((bx * 512 + tid) & 127) * 8;
                f32x4 w0[3], w1[3];
#pragma unroll
                for (int k = 0; k < 3; ++k) { w0[k] = *(const f32x4*)(cw + k * D + c8); w1[k] = *(const f32x4*)(cw + k * D + c8 + 4); }
                for (int sl = (bx * 512 + tid) >> 7; sl < T / 16; sl += (G * 512) >> 7) { const int tg0 = sl * 16;
                    u32x4 zr[18], br[16];
#pragma unroll
                    for (int j = 0; j < 18; ++j) { const int tg = tg0 - 2 + j; zr[j] = *(const u32x4*)(zcb + (size_t)(tg < 0 ? 0 : tg) * D + c8); }
#pragma unroll
                    for (int j = 0; j < 16; ++j) br[j] = *(const u32x4*)(bgate + (size_t)(tg0 + j) * D + c8);
                    if ((tg0 % S) == 0) { zr[0] = (u32x4){0u, 0u, 0u, 0u}; zr[1] = zr[0]; }
#pragma unroll
                    for (int j = 0; j < 16; ++j) { f32x4 a0 = (f32x4){0.f, 0.f, 0.f, 0.f}, a1 = a0;
#pragma unroll
                        for (int k = 0; k < 3; ++k) { f32x4 z0, z1; unpack8(zr[j + k], z0, z1); a0 += w0[k] * z0; a1 += w1[k] * z1; }
                        f32x4 b0, b1; unpack8(br[j], b0, b1);
                        st16(g2b + (size_t)(tg0 + j) * D + c8, pack8(b0 * a0, b1 * a1)); }
                }
                SEAM(PH_CONV);
            }
            if (IN(PH_CONVOUT)) { PH_ENTER
                SchedPlain Sd{T / BM, D / BM, G, bx, D, (const char*)(ws + WS_WOUTC)};
                EpiResid E{hb};
                gemm_phase<EpiResid, SchedPlain, true, true>(lds, tid, (const char*)g2b, D, Sd, E);
                SEAM(PH_CONVOUT);
            }
        }
    }
#if DBG
    if (IN(NPHASE - 1)) { PH_ENTER
        xcd_barrier(bar);
        float* acc = (float*)(ctl + CW_DBG);
        const float fn = __hip_atomic_load(acc, __ATOMIC_RELAXED, __HIP_MEMORY_SCOPE_AGENT), fd = __hip_atomic_load(acc + 1, __ATOMIC_RELAXED, __HIP_MEMORY_SCOPE_AGENT);
        if (!(fn <= DBG_TOL * fd) && bx == 0) hout[tid] = __builtin_nanf("");
    }
#endif
#undef IN
#undef SEAM
}
}

extern "C" void kernel_launch(void* const* d_in, const int* in_sizes, int n_in, void* d_out, int out_size, void* d_ws, size_t ws_size, hipStream_t stream) {
    static int grid = 0;
    if (grid == 0) {
        if (n_in != 27 || out_size != T * D || ws_size < WS_END) { fprintf(stderr, "kernel_launch: unexpected shapes (n_in %d out %d ws %zu)\n", n_in, out_size, ws_size); grid = -1; return; }
        int dev = 0, cus = 0, per_cu = 0;
        if (hipGetDevice(&dev) != hipSuccess || hipDeviceGetAttribute(&cus, hipDeviceAttributeMultiprocessorCount, dev) != hipSuccess) { grid = -1; return; }
        if (hipFuncSetAttribute((const void*)fwd, hipFuncAttributeMaxDynamicSharedMemorySize, LDS_BYTES) != hipSuccess) { fprintf(stderr, "kernel_launch: hipFuncSetAttribute failed\n"); grid = -1; return; }
        if (hipOccupancyMaxActiveBlocksPerMultiprocessor(&per_cu, (const void*)fwd, 512, LDS_BYTES) != hipSuccess || per_cu < 1) { fprintf(stderr, "kernel_launch: occupancy query says %d\n", per_cu); }
        (void)hipGetLastError();
        grid = cus;
    }
    if (grid < 0) return;
    (void)hipMemsetAsync((char*)d_ws + WS_CTL, 0, CTL_BYTES, stream);
    Args a{};
    for (int i = 0; i < 27; ++i) a.in[i] = (const float*)d_in[i];
    a.out = (float*)d_out; a.ws = (unsigned char*)d_ws;
    if (NLAUNCH == 1) { a.ph_lo = 0; a.ph_hi = NPHASE; hipLaunchKernelGGL(fwd, dim3(grid), dim3(512), LDS_BYTES, stream, a); }
    else for (int p = 0; p < NPHASE; ++p) { a.ph_lo = p; a.ph_hi = p + 1;
        if ((DRY_MASK >> p) & 1u) { a.dry = DRY_KIND; hipLaunchKernelGGL(fwd, dim3(grid), dim3(512), LDS_BYTES, stream, a); a.dry = 0; }
        const int reps = ((REPEAT_MASK >> p) & 1u) ? 2 : 1;
        for (int r = 0; r < reps; ++r) hipLaunchKernelGGL(fwd, dim3(grid), dim3(512), LDS_BYTES, stream, a); }
}
```

```cpp
#include <hip/hip_runtime.h>
#include <cstdio>
#include <cstdint>

#ifndef NLAUNCH
#define NLAUNCH 1
#endif

#ifndef DRY_MASK
#define DRY_MASK 0u
#endif
#ifndef DRY_KIND
#define DRY_KIND 1
#endif
#ifndef REPEAT_MASK
#define REPEAT_MASK 0u
#endif
#define LAS __attribute__((address_space(3)))
typedef unsigned short bf16_t;
typedef short bf16x8 __attribute__((ext_vector_type(8)));
typedef float f32x4 __attribute__((ext_vector_type(4)));
typedef unsigned u32x4 __attribute__((ext_vector_type(4)));
typedef unsigned u32x2 __attribute__((ext_vector_type(2)));

namespace {
constexpr int D = 1024, NB = 2, S = 8192, T = NB * S;
constexpr int SSMW = 640, NG = 40, GS = 16, NS = 64;
constexpr int AH = 6, HD = 64, AW = 384, MIXIN = 1792, GLUN = 768, CONVN = 3072;
constexpr int NE = 32, DE = 512, CAP = T, MAXROWS = 40960;
constexpr float EPS = 1e-6f;
constexpr int NPHASE = 17;
constexpr int RT_SPLIT = 8;
constexpr int FILL_G2 = 8192;
constexpr int FILL_IN = 3072, FILL_GLU = 3072;
enum { PH_PRO = 0, PH_INPROJ, PH_ATTN, PH_SSMY, PH_GLU, PH_OUT0, PH_RT0, PH_G1_0, PH_G2_0, PH_CMB0, PH_CONVIN, PH_CONV, PH_CONVOUT, PH_RT1, PH_G1_1, PH_G2_1, PH_CMB1 };
#ifndef DBG
#define DBG 0
#endif
#define DBG_TOL 1e-4f

constexpr size_t MiB = 1u << 20;
constexpr size_t WS_CTL = 0, CTL_BYTES = 256 * 1024;
constexpr size_t WS_RSMIX = 1 * MiB, WS_RSFFN = 1 * MiB + 512 * 1024;
constexpr size_t WS_TOKROW = 2 * MiB;
constexpr size_t WS_LIST = 3 * MiB, WS_GATEL = 5 * MiB;
constexpr size_t WS_WRT = 7 * MiB;
constexpr size_t WS_WIN0 = 16 * MiB, WS_WGLU = 20 * MiB, WS_WOUT0 = 21 * MiB, WS_WINC = 23 * MiB, WS_WOUTC = 29 * MiB;
constexpr size_t WS_WGU = 32 * MiB, WS_WD = 96 * MiB, WS_MOE_LAYER = 96 * MiB;
constexpr size_t WS_HB = 224 * MiB;
constexpr size_t WS_PROJ = 256 * MiB, WS_CONCAT = 312 * MiB, WS_YSSM = 344 * MiB;
constexpr size_t WS_BGATE = 256 * MiB, WS_ZC = 288 * MiB, WS_G2 = 320 * MiB;
constexpr size_t WS_H = 364 * MiB, WS_Y = 404 * MiB, WS_END = 494 * MiB;
constexpr size_t WS_HB8 = 208 * MiB;
constexpr size_t WS_UG = 474 * MiB;
constexpr size_t WS_LAM = 404 * MiB  , WS_KF = 406 * MiB  , WS_CT = 408 * MiB  , WS_BEND = 409 * MiB, WS_SEND = 420 * MiB, WS_SIN = 426 * MiB;
constexpr size_t WS_OPART = 432 * MiB, WS_MPART = 470 * MiB, WS_LPART = 472 * MiB;
constexpr size_t WS_DBGA = 364 * MiB, WS_DBGB = 384 * MiB;
constexpr int CW_BAR = 4096;
constexpr int CW_CNT = 16384;
constexpr int CW_DBG = 40960;

constexpr int RING_BYTES = 131072;
constexpr int TAB_OFF = RING_BYTES;
constexpr int TAB_TILE_E = TAB_OFF, TAB_TILE_M = TAB_OFF + 768, TAB_NT = TAB_OFF + 1536, TAB_TOK = TAB_OFF + 2048, TAB_GATE = TAB_OFF + 2048 + 4096;
constexpr int MISC_OFF = TAB_OFF + 2048 + 8192;
constexpr int LDS_BYTES = MISC_OFF + 256;

__device__ __forceinline__ unsigned cvt_pk_bf16(float lo, float hi) { unsigned r; asm volatile("v_cvt_pk_bf16_f32 %0, %1, %2" : "=v"(r) : "v"(lo), "v"(hi)); return r; }
__device__ __forceinline__ float bf_lo(unsigned w) { return __uint_as_float(w << 16); }
__device__ __forceinline__ float bf_hi(unsigned w) { return __uint_as_float(w & 0xffff0000u); }
__device__ __forceinline__ float bf2f(bf16_t b) { return __uint_as_float(((unsigned)b) << 16); }
__device__ __forceinline__ unsigned f2bf(float f) { unsigned u = __float_as_uint(f); return (u + 0x7fffu + ((u >> 16) & 1u)) >> 16; }
__device__ __forceinline__ unsigned pk2(float lo, float hi) { return f2bf(lo) | (f2bf(hi) << 16); }
__device__ __forceinline__ u32x4 pack8(f32x4 a, f32x4 b) { u32x4 w; w.x = cvt_pk_bf16(a[0], a[1]); w.y = cvt_pk_bf16(a[2], a[3]); w.z = cvt_pk_bf16(b[0], b[1]); w.w = cvt_pk_bf16(b[2], b[3]); return w; }
__device__ __forceinline__ void unpack8(u32x4 w, f32x4& a, f32x4& b) { a = (f32x4){bf_lo(w.x), bf_hi(w.x), bf_lo(w.y), bf_hi(w.y)}; b = (f32x4){bf_lo(w.z), bf_hi(w.z), bf_lo(w.w), bf_hi(w.w)}; }
#ifndef WT_STORES
#define WT_STORES 0
#endif
__device__ __forceinline__ void st16(void* p, u32x4 v) {
#if WT_STORES
    asm volatile("global_store_dwordx4 %0, %1, off sc1\n\ts_nop 1" :: "v"(p), "v"(v) : "memory");
#else
    *(u32x4*)p = v;
#endif
}
__device__ __forceinline__ void st16f(void* p, f32x4 v) { st16(p, __builtin_bit_cast(u32x4, v)); }
__device__ __forceinline__ float wave_sum(float v) {
#pragma unroll
    for (int o = 1; o < 64; o <<= 1) v += __shfl_xor(v, o);
    return v;
}
__device__ __forceinline__ int lane_now() { int l; asm volatile("v_mbcnt_lo_u32_b32 %0, -1, 0\n\tv_mbcnt_hi_u32_b32 %0, -1, %0" : "=v"(l)); return l; }
__device__ __forceinline__ int bperm(int src_lane, int v) { return __builtin_amdgcn_ds_bpermute(src_lane << 2, v); }
__device__ __forceinline__ float shx(float v, int k, int lane) { return __builtin_bit_cast(float, bperm(lane ^ k, __builtin_bit_cast(int, v))); }
__device__ __forceinline__ float wave_sum_l(float v, int lane) {
#pragma unroll
    for (int o = 1; o < 64; o <<= 1) v += shx(v, o, lane);
    return v;
}
__device__ __forceinline__ float wave_max(float v) {
#pragma unroll
    for (int o = 1; o < 64; o <<= 1) v = fmaxf(v, __shfl_xor(v, o));
    return v;
}
__device__ __forceinline__ float sigmoidf_(float z) { return __builtin_amdgcn_rcpf(1.f + __expf(-z)); }
__device__ __forceinline__ float gelu_tanh(float x) {
    const float z = x * (2.3022082f + 0.10294324f * x * x);
    return x * __builtin_amdgcn_rcpf(1.f + __builtin_amdgcn_exp2f(-z));
}

typedef __attribute__((address_space(1))) unsigned char GAS_U8;
typedef __attribute__((address_space(1))) float GAS_F32;
typedef float f32x2 __attribute__((ext_vector_type(2)));
typedef int v8i __attribute__((ext_vector_type(8)));
typedef int i32x4 __attribute__((ext_vector_type(4)));
__device__ __forceinline__ u32x2 pack8_fp8(f32x4 a, f32x4 b) { int w0 = 0, w1 = 0;
#pragma unroll
    for (int j = 0; j < 4; ++j) { a[j] = __builtin_amdgcn_fmed3f(a[j], -448.f, 448.f); b[j] = __builtin_amdgcn_fmed3f(b[j], -448.f, 448.f); }
    w0 = __builtin_amdgcn_cvt_pk_fp8_f32(a[0], a[1], w0, false); w0 = __builtin_amdgcn_cvt_pk_fp8_f32(a[2], a[3], w0, true);
    w1 = __builtin_amdgcn_cvt_pk_fp8_f32(b[0], b[1], w1, false); w1 = __builtin_amdgcn_cvt_pk_fp8_f32(b[2], b[3], w1, true);
    return (u32x2){(unsigned)w0, (unsigned)w1}; }
__device__ __forceinline__ unsigned pack4_fp8(f32x4 a) { int w = 0;
#pragma unroll
    for (int j = 0; j < 4; ++j) a[j] = __builtin_amdgcn_fmed3f(a[j], -448.f, 448.f);
    w = __builtin_amdgcn_cvt_pk_fp8_f32(a[0], a[1], w, false); w = __builtin_amdgcn_cvt_pk_fp8_f32(a[2], a[3], w, true); return (unsigned)w; }
constexpr int F8_SCALE_ONE = 127, F8_SCALE_WGU = 122  , F8_SCALE_WD = 123  ;
constexpr int BM = 256, BK = 64, HALF = 128, HTB = HALF * BK * 2, NXCD = 8, WGM = 8;
__host__ __device__ __forceinline__ int lds_byte(int r, int c) { const int st = (r >> 4) * 2 + (c >> 5), rr = r & 15, cc = c & 31, ob = rr * 64 + cc * 2; return st * 1024 + (ob ^ (((ob >> 9) & 1) << 5)); }
__host__ __device__ __forceinline__ void stage_rc(int b, int& R, int& C) { const int st = b / 1024, sb = b % 1024, swz = sb ^ (((sb >> 9) & 1) << 5); R = (st >> 1) * 16 + swz / 64; C = (st & 1) * 32 + (swz % 64) / 2; }
__device__ __forceinline__ void stage_rc_u(unsigned b, int& R, int& C) { const unsigned st = b >> 10, sb = b & 1023u, swz = sb ^ (((sb >> 9) & 1u) << 5); R = (int)((st >> 1) * 16u + (swz >> 6)); C = (int)((st & 1u) * 32u + ((swz & 63u) >> 1)); }
__host__ __device__ __forceinline__ int perm32(int rho) { const int n = rho >> 4, i = rho & 15; return 8 * (i >> 2) + 4 * n + (i & 3); }

struct Unit { int pm, pn, e, half; const char* B; };
__device__ __forceinline__ void unit_map(int L, int nM, int nN, int& pm, int& pn) {
    const int nwg = nM * nN; int wgid = L;
    { const int q = nwg / NXCD, r = nwg % NXCD, xcd = wgid % NXCD, off = wgid / NXCD; wgid = (xcd < r ? xcd * (q + 1) : r * (q + 1) + (xcd - r) * q) + off; }
    const int nig = WGM * nN, gid = wgid / nig, fm = gid * WGM, gsz = (nM - fm) < WGM ? (nM - fm) : WGM;
    pm = fm + ((wgid % nig) % gsz); pn = (wgid % nig) / gsz;
}
struct SchedPlain {
    int nM, nN, G, c, K; const char* Bt; int es;
    __device__ __forceinline__ bool next(int i, Unit& u) const {
        const int L = i * G + c; if (L >= nM * nN) return false;
        unit_map(L, nM, nN, u.pm, u.pn); u.e = 0; u.half = 0; u.B = Bt + (size_t)u.pn * BM * K * es; return true;
    }
    __device__ __forceinline__ void aoffs(const Unit& u, int, const int (&R)[2], const int (&C)[2], unsigned (&o)[2][2]) const {
#pragma unroll
        for (int h = 0; h < 2; ++h)
#pragma unroll
            for (int i = 0; i < 2; ++i) o[h][i] = (unsigned)((u.pm * BM + h * HALF + R[i]) * K * es + C[i] * 2);
    }
};
struct SchedMoe {
    int ntiles, nN, G, c, K; const char* Bt; size_t strideB; const LAS int* tile_e; const LAS int* tok; const LAS int* tile_m; const LAS int* cntL; int es;
    __device__ __forceinline__ bool next(int i, Unit& u) const {
        const int L = i * G + c; if (L >= ntiles * nN) return false;
        unit_map(L, ntiles, nN, u.pm, u.pn); u.e = tile_e[u.pm]; u.half = (cntL[u.e] - tile_m[u.pm] * 256) <= HALF ? 1 : 0; u.B = Bt + (size_t)u.e * strideB + (size_t)u.pn * BM * K * es; return true;
    }
    __device__ __forceinline__ void aoffs(const Unit& u, int ui, const int (&R)[2], const int (&C)[2], unsigned (&o)[2][2]) const {
#pragma unroll
        for (int h = 0; h < 2; ++h)
#pragma unroll
            for (int i = 0; i < 2; ++i) {
                const int row = tok ? tok[ui * 256 + h * HALF + R[i]] : (u.pm * BM + h * HALF + R[i]);
                o[h][i] = (unsigned)(row * K * es + C[i] * 2);
            }
    }
};

struct SchedSsm {
    int G, c; const char* Bt;
    __device__ __forceinline__ bool next(int i, Unit& u) const {
        const int g = c - (G - NG); if (i != 0 || g < 0) return false;
        u.pm = g; u.pn = 0; u.e = g; u.half = 0; u.B = Bt + (size_t)g * 128 * 1024 * 2; return true;
    }
    __device__ __forceinline__ void aoffs(const Unit& u, int, const int (&R)[2], const int (&C)[2], unsigned (&o)[2][2]) const {
#pragma unroll
        for (int h = 0; h < 2; ++h)
#pragma unroll
            for (int i = 0; i < 2; ++i) o[h][i] = (unsigned)(((u.pm * BM + h * HALF + R[i]) * 1024 + C[i]) * 2);
    }
};
typedef f32x4 Acc[2][2][4][2];

struct EpiProj {
    static constexpr bool PERM = true;
    bf16_t* O; bf16_t* ug; const float* rs; const float* qn; const float* kn;
    __device__ __forceinline__ void operator()(const Acc& acc, const Unit& u, int, int wr, int wc, int fr, int fq) const {
        const int row0 = u.pm * BM + wr * 64 + fr, sigma = u.pn * 4 + wc, col0 = sigma * 64 + 8 * fq;
        const int kind = (sigma >= 10 && sigma < 16) ? 1 : ((sigma >= 16 && sigma < 22) ? 2 : 0);
        f32x4 w[2][2];
#pragma unroll
        for (int bj = 0; bj < 2; ++bj)
#pragma unroll
            for (int n = 0; n < 2; ++n) w[bj][n] = kind ? *(const f32x4*)((kind == 1 ? qn : kn) + 32 * bj + 8 * fq + 4 * n) : (f32x4){1.f, 1.f, 1.f, 1.f};
        float sv[2][4];
#pragma unroll
        for (int ai = 0; ai < 2; ++ai)
#pragma unroll
            for (int m = 0; m < 4; ++m) sv[ai][m] = rs[row0 + ai * HALF + m * 16];
#pragma unroll
        for (int ai = 0; ai < 2; ++ai)
#pragma unroll
            for (int m = 0; m < 4; ++m) { const int row = row0 + ai * HALF + m * 16; const float s = sv[ai][m];
                f32x4 v[2][2]; float ss = 0.f;
#pragma unroll
                for (int bj = 0; bj < 2; ++bj)
#pragma unroll
                    for (int n = 0; n < 2; ++n) { v[bj][n] = acc[ai][bj][m][n] * s; ss += (v[bj][n][0] * v[bj][n][0] + v[bj][n][1] * v[bj][n][1]) + (v[bj][n][2] * v[bj][n][2] + v[bj][n][3] * v[bj][n][3]); }
                if (kind) { ss += __shfl_xor(ss, 16); ss += __shfl_xor(ss, 32);
                    const float r = rsqrtf(ss * (1.f / HD) + EPS) * (kind == 1 ? 0.125f * 1.4426950408889634f : 1.f);
#pragma unroll
                    for (int bj = 0; bj < 2; ++bj)
#pragma unroll
                        for (int n = 0; n < 2; ++n) v[bj][n] = v[bj][n] * r * w[bj][n]; }
                if (sigma < 10) {
                    bf16_t* up = ug + (((size_t)(4 * sigma + (fq >> 1)) * NB + (row / S)) * S + (row % S)) * GS + 8 * (fq & 1);
#pragma unroll
                    for (int bj = 0; bj < 2; ++bj) st16(up + (size_t)2 * bj * NB * S * GS, pack8(v[bj][0], v[bj][1]));
                } else { bf16_t* rowp = O + (size_t)row * MIXIN + col0;
#pragma unroll
                    for (int bj = 0; bj < 2; ++bj) st16(rowp + 32 * bj, pack8(v[bj][0], v[bj][1])); } }
    }
};
struct EpiSend {
    static constexpr bool PERM = true;
    float* send;
    __device__ __forceinline__ void operator()(const Acc& acc, const Unit& u, int, int wr, int wc, int fr, int fq) const {
#pragma unroll
        for (int ai = 0; ai < 2; ++ai)
#pragma unroll
            for (int m = 0; m < 4; ++m) { const int c = wr * 64 + m * 16 + fr;
                float* o = send + ((size_t)(ai * NG + u.pm) * 128 + c) * 128 + wc * 32 + 8 * fq;
                st16f(o, acc[ai][0][m][0]); st16f(o + 4, acc[ai][0][m][1]); }
    }
};
struct EpiGlu {
    static constexpr bool PERM = true;
    const bf16_t* y; bf16_t* O; const float* bias;
    __device__ __forceinline__ void operator()(const Acc& acc, const Unit& u, int, int wr, int wc, int fr, int fq) const {
        const int row0 = u.pm * BM + wr * 64 + fr, col0 = u.pn * BM + wc * 32 + 8 * fq;
#pragma unroll
        for (int bj = 0; bj < 2; ++bj) {
            const int col = col0 + bj * HALF; if (col >= SSMW) continue;
            const f32x4 b0 = *(const f32x4*)(bias + col), b1 = *(const f32x4*)(bias + col + 4);
            u32x4 yv[2][4];
#pragma unroll
            for (int ai = 0; ai < 2; ++ai)
#pragma unroll
                for (int m = 0; m < 4; ++m) yv[ai][m] = *(const u32x4*)(y + (size_t)(row0 + ai * HALF + m * 16) * SSMW + col);
#pragma unroll
            for (int ai = 0; ai < 2; ++ai)
#pragma unroll
                for (int m = 0; m < 4; ++m) { const int row = row0 + ai * HALF + m * 16;
                    f32x4 y0, y1; unpack8(yv[ai][m], y0, y1);
                    const f32x4 z0 = acc[ai][bj][m][0] + b0, z1 = acc[ai][bj][m][1] + b1;
                    f32x4 o0, o1;
#pragma unroll
                    for (int j = 0; j < 4; ++j) { o0[j] = y0[j] * sigmoidf_(z0[j]); o1[j] = y1[j] * sigmoidf_(z1[j]); }
                    st16(O + (size_t)row * D + col, pack8(o0, o1)); }
        }
    }
};
struct EpiResid {
    static constexpr bool PERM = true;
    bf16_t* hb; unsigned char* hb8;
    __device__ __forceinline__ void operator()(const Acc& acc, const Unit& u, int, int wr, int wc, int fr, int fq) const {
        const int row0 = u.pm * BM + wr * 64 + fr, col0 = u.pn * BM + wc * 32 + 8 * fq;
        u32x4 rr[2][4][2];
#pragma unroll
        for (int ai = 0; ai < 2; ++ai)
#pragma unroll
            for (int m = 0; m < 4; ++m)
#pragma unroll
                for (int bj = 0; bj < 2; ++bj) rr[ai][m][bj] = *(const u32x4*)(hb + (size_t)(row0 + ai * HALF + m * 16) * D + col0 + bj * HALF);
#pragma unroll
        for (int ai = 0; ai < 2; ++ai)
#pragma unroll
            for (int m = 0; m < 4; ++m) { const size_t off = (size_t)(row0 + ai * HALF + m * 16) * D + col0;
#pragma unroll
                for (int bj = 0; bj < 2; ++bj) { const size_t o = off + bj * HALF;
                    f32x4 r0, r1; unpack8(rr[ai][m][bj], r0, r1);
                    const f32x4 v0 = r0 + acc[ai][bj][m][0], v1 = r1 + acc[ai][bj][m][1];
                    st16(hb + o, pack8(v0, v1));
                    if (hb8) *(u32x2*)(hb8 + o) = pack8_fp8(v0, v1); } }
    }
};
struct EpiMoe1 {
    static constexpr bool PERM = true;
    bf16_t* H; const float* rs; const LAS int* tok;
    __device__ __forceinline__ void operator()(const Acc& acc, const Unit& u, int ui, int wr, int wc, int fr, int fq) const {
        const int r0 = wr * 64 + fr, col0 = u.pn * HALF + wc * 32 + 8 * fq;
#pragma unroll
        for (int ai = 0; ai < 2; ++ai)
#pragma unroll
            for (int m = 0; m < 4; ++m) { const int r = r0 + ai * HALF + m * 16; const float s = rs[tok[ui * 256 + r]];
                f32x4 o0, o1;
#pragma unroll
                for (int j = 0; j < 4; ++j) { const float g0 = acc[ai][0][m][0][j] * s, g1 = acc[ai][0][m][1][j] * s;
                    o0[j] = g0 * sigmoidf_(g0) * (acc[ai][1][m][0][j] * s); o1[j] = g1 * sigmoidf_(g1) * (acc[ai][1][m][1][j] * s); }
                st16(H + (size_t)(u.pm * BM + r) * DE + col0, pack8(o0, o1)); }
    }
};
struct EpiMoe1F8 {
    static constexpr bool PERM = true;
    unsigned char* H; const float* rs; const LAS int* tok;
    __device__ __forceinline__ void operator()(const Acc& acc, const Unit& u, int ui, int wr, int wc, int fr, int fq) const {
        const int r0 = wr * 64 + fr, col0 = u.pn * HALF + wc * 32 + 8 * fq;
        float sv[2][4];
#pragma unroll
        for (int ai = 0; ai < 2; ++ai)
#pragma unroll
            for (int m = 0; m < 4; ++m) sv[ai][m] = rs[tok[ui * 256 + r0 + ai * HALF + m * 16]];
#pragma unroll
        for (int ai = 0; ai < 2; ++ai)
#pragma unroll
            for (int m = 0; m < 4; ++m) { const int r = r0 + ai * HALF + m * 16; const float s = sv[ai][m];
                f32x4 o0, o1;
#pragma unroll
                for (int j = 0; j < 4; ++j) { const float g0 = acc[ai][0][m][0][j] * s, g1 = acc[ai][0][m][1][j] * s;
                    o0[j] = g0 * sigmoidf_(g0) * (acc[ai][1][m][0][j] * s); o1[j] = g1 * sigmoidf_(g1) * (acc[ai][1][m][1][j] * s); }
                *(u32x2*)(H + (size_t)(u.pm * BM + r) * DE + col0) = pack8_fp8(o0, o1); }
    }
};
struct EpiMoe2 {
    static constexpr bool PERM = true;
    unsigned char* Y; const LAS float* gate;
    __device__ __forceinline__ void operator()(const Acc& acc, const Unit& u, int ui, int wr, int wc, int fr, int fq) const {
        const int r0 = wr * 64 + fr, col0 = u.pn * BM + wc * 32 + 8 * fq;
#pragma unroll
        for (int ai = 0; ai < 2; ++ai)
#pragma unroll
            for (int m = 0; m < 4; ++m) { const int r = r0 + ai * HALF + m * 16; const float s = gate[ui * 256 + r] * 16.f; unsigned char* rowp = Y + (size_t)(u.pm * BM + r) * D + col0;
#pragma unroll
                for (int bj = 0; bj < 2; ++bj) *(u32x2*)(rowp + bj * HALF) = pack8_fp8(acc[ai][bj][m][0] * s, acc[ai][bj][m][1] * s); }
    }
};
struct EpiConvIn {
    static constexpr bool PERM = true;
    bf16_t* bg; bf16_t* zc; const float* rs;
    __device__ __forceinline__ void operator()(const Acc& acc, const Unit& u, int, int wr, int wc, int fr, int fq) const {
        const int row0 = u.pm * BM + wr * 64 + fr;
        float sv[2][4];
#pragma unroll
        for (int ai = 0; ai < 2; ++ai)
#pragma unroll
            for (int m = 0; m < 4; ++m) sv[ai][m] = rs[row0 + ai * HALF + m * 16];
#pragma unroll
        for (int ai = 0; ai < 2; ++ai)
#pragma unroll
            for (int m = 0; m < 4; ++m) { const int row = row0 + ai * HALF + m * 16; const float s = sv[ai][m];
                if (u.pn < 4) { bf16_t* rowp = bg + (size_t)row * D + u.pn * BM + wc * 32 + 8 * fq;
#pragma unroll
                    for (int bj = 0; bj < 2; ++bj) st16(rowp + bj * HALF, pack8(acc[ai][bj][m][0] * s, acc[ai][bj][m][1] * s));
                } else { const float s2 = s * s;
                    st16(zc + (size_t)row * D + (u.pn - 4) * HALF + wc * 32 + 8 * fq, pack8(acc[ai][0][m][0] * acc[ai][1][m][0] * s2, acc[ai][0][m][1] * acc[ai][1][m][1] * s2)); } }
    }
};

template <class Epi, class Sched, bool ALIGN_EPI, bool SP2>
__device__ __forceinline__ void gemm_phase(LAS unsigned char* lds, const int tid, const char* Abase, const int K, const Sched& S, const Epi& E) {
    const int wid = __builtin_amdgcn_readfirstlane(tid >> 6), lane = tid & 63, wr = wid >> 2, wc = wid & 3, fr = lane & 15, fq = lane >> 4;
    const int nt = K / BK;
    int Rr[2], Cc[2]; unsigned voffB[2];
#pragma unroll
    for (int i = 0; i < 2; ++i) { int R, C; stage_rc(tid * 16 + i * 8192, R, C); Rr[i] = R; Cc[i] = C; const int Rb = Epi::PERM ? ((R & ~31) + perm32(R & 31)) : R; voffB[i] = (unsigned)(Rb * K + C) * 2u; }
    const size_t kstep = (size_t)(BK * 2);
    const size_t hstep = (size_t)HALF * K * 2;
    const unsigned ldsw = (unsigned)wid * 1024u;
    const int aoff = lds_byte(wr * 64 + fr, fq * 8), boff = lds_byte(wc * 32 + fr, fq * 8);
#define PG8_SA(b, h) (((b) * 2 + (h)) * HTB)
#define PG8_SB(b, h) ((4 + (b) * 2 + (h)) * HTB)
#define PG8_STAGEB(bufoff, gbase) do { _Pragma("unroll") for (int _i = 0; _i < 2; ++_i) \
        __builtin_amdgcn_global_load_lds((const unsigned*)((const char*)(gbase) + voffB[_i]), (LAS unsigned*)(lds + (bufoff) + ldsw + _i * 8192), 16, 0, 0); } while (0)
#define PG8_STAGEA(bufoff, kb, offs, h) do { _Pragma("unroll") for (int _i = 0; _i < 2; ++_i) \
        __builtin_amdgcn_global_load_lds((const unsigned*)(Abase + (size_t)(kb) + (offs)[h][_i]), (LAS unsigned*)(lds + (bufoff) + ldsw + _i * 8192), 16, 0, 0); } while (0)
#define PG8_LDA(dst, b, h) do { _Pragma("unroll") for (int m = 0; m < 4; ++m) _Pragma("unroll") for (int k = 0; k < 2; ++k) dst[m][k] = *(const LAS bf16x8*)(lds + PG8_SA(b, h) + aoff + m * 2048 + k * 1024); } while (0)
#define PG8_LDB(dst, b, h) do { _Pragma("unroll") for (int n = 0; n < 2; ++n) _Pragma("unroll") for (int k = 0; k < 2; ++k) dst[n][k] = *(const LAS bf16x8*)(lds + PG8_SB(b, h) + boff + n * 2048 + k * 1024); } while (0)
#define PG8_MMA(ai, bj, At, Bt) do { __builtin_amdgcn_s_setprio(1); _Pragma("unroll") for (int m = 0; m < 4; ++m) _Pragma("unroll") for (int n = 0; n < 2; ++n) _Pragma("unroll") for (int k = 0; k < 2; ++k) \
        acc[ai][bj][m][n] = __builtin_amdgcn_mfma_f32_16x16x32_bf16(Bt[n][k], At[m][k], acc[ai][bj][m][n], 0, 0, 0); __builtin_amdgcn_s_setprio(0); } while (0)
#define PG8_WAIT_V(n) asm volatile("s_waitcnt vmcnt(" #n ")" ::: "memory")
#define PG8_WAIT_L(n) asm volatile("s_waitcnt lgkmcnt(" #n ")" ::: "memory")
#define PG8_BAR __builtin_amdgcn_s_barrier()
#define PG8_SCHED __builtin_amdgcn_sched_barrier(0)
    Unit cur, nxt; int ui = 0;
    if (!S.next(0, cur)) return;
    Acc acc;
#pragma unroll
    for (int a = 0; a < 2; ++a)
#pragma unroll
        for (int b = 0; b < 2; ++b)
#pragma unroll
            for (int m = 0; m < 4; ++m)
#pragma unroll
                for (int n = 0; n < 2; ++n) acc[a][b][m][n] = (f32x4){0.f, 0.f, 0.f, 0.f};
    bf16x8 At[4][2], B0[2][2], B1[2][2];
    unsigned ca[2][2], na[2][2];
    S.aoffs(cur, 0, Rr, Cc, ca);
    const char* cB = cur.B;
    if constexpr (SP2) {
        PG8_STAGEB(PG8_SB(0, 0), cB); PG8_STAGEB(PG8_SB(0, 1), cB + hstep); PG8_STAGEA(PG8_SA(0, 0), 0, ca, 0); PG8_STAGEA(PG8_SA(0, 1), 0, ca, 1);
        if (wr == 1) PG8_BAR;
        PG8_WAIT_V(2); PG8_BAR;
        PG8_STAGEB(PG8_SB(1, 0), cB + kstep); PG8_STAGEA(PG8_SA(1, 0), kstep, ca, 0); PG8_STAGEB(PG8_SB(1, 1), cB + hstep + kstep);
        PG8_WAIT_V(6); PG8_BAR;
    } else {
        PG8_STAGEB(PG8_SB(0, 0), cB); PG8_STAGEA(PG8_SA(0, 0), 0, ca, 0); PG8_STAGEB(PG8_SB(0, 1), cB + hstep); PG8_STAGEA(PG8_SA(0, 1), 0, ca, 1);
        if (wr == 1) PG8_BAR;
        PG8_WAIT_V(4); PG8_BAR;
        PG8_STAGEB(PG8_SB(1, 0), cB + kstep); PG8_STAGEA(PG8_SA(1, 0), kstep, ca, 0); PG8_STAGEB(PG8_SB(1, 1), cB + hstep + kstep);
        PG8_WAIT_V(6); PG8_BAR;
    }
    for (;;) {
        const bool has_next = S.next(ui + 1, nxt);
        if (has_next) S.aoffs(nxt, ui + 1, Rr, Cc, na);
        else {
#pragma unroll
            for (int h = 0; h < 2; ++h)
#pragma unroll
                for (int i = 0; i < 2; ++i) na[h][i] = ca[h][i];
        }
        const char* nB = has_next ? nxt.B : cB;
        for (int t = 0; t < nt; t += 2) {
            const bool last = (t == nt - 2);
            const size_t k1 = (size_t)(t + 1) * kstep;
            const size_t k2 = last ? 0 : (size_t)(t + 2) * kstep, k3 = k2 + kstep;
            unsigned o2[2][2];
#pragma unroll
            for (int h = 0; h < 2; ++h)
#pragma unroll
                for (int i = 0; i < 2; ++i) o2[h][i] = last ? na[h][i] : ca[h][i];
            const char* b2 = last ? nB : cB + (size_t)(t + 2) * kstep; const char* b3 = b2 + kstep;
            if constexpr (SP2) {
            PG8_LDB(B0, 0, 0); PG8_LDB(B1, 0, 1); PG8_SCHED; PG8_LDA(At, 0, 0); PG8_STAGEA(PG8_SA(1, 1), k1, ca, 1);
            PG8_WAIT_V(8); PG8_WAIT_L(0); PG8_BAR; PG8_MMA(0, 0, At, B0); PG8_MMA(0, 1, At, B1); PG8_BAR; PG8_SCHED;
            PG8_LDA(At, 0, 1); PG8_STAGEB(PG8_SB(0, 0), b2); PG8_STAGEB(PG8_SB(0, 1), b2 + hstep); PG8_STAGEA(PG8_SA(0, 0), k2, o2, 0);
            PG8_WAIT_V(8); PG8_WAIT_L(0); PG8_BAR; if (!cur.half) { PG8_MMA(1, 0, At, B0); PG8_MMA(1, 1, At, B1); } PG8_BAR; PG8_SCHED;
            PG8_LDB(B0, 1, 0); PG8_LDB(B1, 1, 1); PG8_SCHED; PG8_LDA(At, 1, 0); PG8_STAGEA(PG8_SA(0, 1), k2, o2, 1);
            PG8_WAIT_V(8); PG8_WAIT_L(0); PG8_BAR; PG8_MMA(0, 0, At, B0); PG8_MMA(0, 1, At, B1); PG8_BAR; PG8_SCHED;
            PG8_LDA(At, 1, 1); PG8_STAGEB(PG8_SB(1, 0), b3); PG8_STAGEB(PG8_SB(1, 1), b3 + hstep); PG8_STAGEA(PG8_SA(1, 0), k3, o2, 0);
            PG8_WAIT_V(8); PG8_WAIT_L(0); PG8_BAR; if (!cur.half) { PG8_MMA(1, 0, At, B0); PG8_MMA(1, 1, At, B1); } PG8_BAR; PG8_SCHED;
            } else {
            PG8_LDB(B0, 0, 0); PG8_SCHED; PG8_LDA(At, 0, 0); PG8_STAGEA(PG8_SA(1, 1), k1, ca, 1);
            PG8_WAIT_L(8); PG8_BAR; PG8_WAIT_L(0); PG8_MMA(0, 0, At, B0); PG8_BAR; PG8_SCHED;
            PG8_LDB(B1, 0, 1); PG8_STAGEB(PG8_SB(0, 0), b2);
            PG8_BAR; PG8_WAIT_L(0); PG8_MMA(0, 1, At, B1); PG8_BAR;
            PG8_LDA(At, 0, 1); PG8_STAGEA(PG8_SA(0, 0), k2, o2, 0);
            PG8_BAR; PG8_WAIT_L(0); PG8_MMA(1, 0, At, B0); PG8_BAR; PG8_SCHED;
            PG8_STAGEB(PG8_SB(0, 1), b2 + hstep);
            PG8_WAIT_V(6); PG8_BAR; PG8_MMA(1, 1, At, B1); PG8_BAR;
            PG8_LDB(B0, 1, 0); PG8_SCHED; PG8_LDA(At, 1, 0); PG8_STAGEA(PG8_SA(0, 1), k2, o2, 1);
            PG8_WAIT_L(8); PG8_BAR; PG8_WAIT_L(0); PG8_MMA(0, 0, At, B0); PG8_BAR; PG8_SCHED;
            PG8_LDB(B1, 1, 1); PG8_STAGEB(PG8_SB(1, 0), b3);
            PG8_BAR; PG8_WAIT_L(0); PG8_MMA(0, 1, At, B1); PG8_BAR;
            PG8_LDA(At, 1, 1); PG8_STAGEA(PG8_SA(1, 0), k3, o2, 0);
            PG8_BAR; PG8_WAIT_L(0); PG8_MMA(1, 0, At, B0); PG8_BAR; PG8_SCHED;
            PG8_STAGEB(PG8_SB(1, 1), b3 + hstep);
            PG8_WAIT_V(6); PG8_BAR; PG8_MMA(1, 1, At, B1); PG8_BAR;
            }
        }
        if constexpr (ALIGN_EPI) { if (wr == 0) PG8_BAR; }
        E(acc, cur, ui, wr, wc, fr, fq);
        if (!has_next) break;
#pragma unroll
        for (int a = 0; a < 2; ++a)
#pragma unroll
            for (int b = 0; b < 2; ++b)
#pragma unroll
                for (int m = 0; m < 4; ++m)
#pragma unroll
                    for (int n = 0; n < 2; ++n) acc[a][b][m][n] = (f32x4){0.f, 0.f, 0.f, 0.f};
        cur = nxt; cB = nB; ++ui;
#pragma unroll
        for (int h = 0; h < 2; ++h)
#pragma unroll
            for (int i = 0; i < 2; ++i) ca[h][i] = na[h][i];
        if constexpr (ALIGN_EPI) { if (wr == 1) PG8_BAR; }
    }
    PG8_WAIT_V(0);
    if constexpr (!ALIGN_EPI) { if (wr == 0) PG8_BAR; }
    PG8_BAR;
#undef PG8_SA
#undef PG8_SB
#undef PG8_STAGEA
#undef PG8_STAGEB
#undef PG8_LDA
#undef PG8_LDB
#undef PG8_MMA
#undef PG8_WAIT_V
#undef PG8_WAIT_L
#undef PG8_BAR
#undef PG8_SCHED
}
template <class Epi, class Sched>
__device__ __forceinline__ void gemm_phase8(LAS unsigned char* lds, const int tid, const char* Abase, const int K, const Sched& S, const Epi& E, const int scaleB) {
    const int wid = __builtin_amdgcn_readfirstlane(tid >> 6), lane = tid & 63, wr = wid >> 2, wc = wid & 3, fr = lane & 15, fq = lane >> 4;
    const int nt = K / 128;
    unsigned voffB[2];
#pragma unroll
    for (int i = 0; i < 2; ++i) { int R, C; stage_rc(tid * 16 + i * 8192, R, C); const int Rb = Epi::PERM ? ((R & ~31) + perm32(R & 31)) : R; voffB[i] = (unsigned)(Rb * K + C * 2); }
#define PG8_AOFFS(u_, ui_) do { const unsigned t_ = (unsigned)(wid * 64 + lane_now()); int Rr[2], Cc[2]; stage_rc_u(t_ * 16u, Rr[0], Cc[0]); stage_rc_u(t_ * 16u + 8192u, Rr[1], Cc[1]); S.aoffs(u_, ui_, Rr, Cc, ca); } while (0)
    const size_t kstep = 128;
    const size_t hstep = (size_t)HALF * K;
    const unsigned ldsw = (unsigned)wid * 1024u;
    const int aoff = lds_byte(wr * 64 + fr, fq * 8), boff = lds_byte(wc * 32 + fr, fq * 8);
#define PG8_SA(b, h) (((b) * 2 + (h)) * HTB)
#define PG8_SB(b, h) ((4 + (b) * 2 + (h)) * HTB)
#define PG8_STAGEB(bufoff, gbase) do { _Pragma("unroll") for (int _i = 0; _i < 2; ++_i) { unsigned vb_ = voffB[_i]; asm volatile("" : "+v"(vb_));        \
        __builtin_amdgcn_global_load_lds((const unsigned*)((const char*)(gbase) + vb_), (LAS unsigned*)(lds + (bufoff) + ldsw + _i * 8192), 16, 0, 0); } } while (0)
#define PG8_STAGEA(bufoff, kb, offs, h) do { _Pragma("unroll") for (int _i = 0; _i < 2; ++_i) { unsigned va_ = (offs)[h][_i]; asm volatile("" : "+v"(va_)); \
        __builtin_amdgcn_global_load_lds((const unsigned*)(Abase + (size_t)(kb) + va_), (LAS unsigned*)(lds + (bufoff) + ldsw + _i * 8192), 16, 0, 0); } } while (0)
#define PG8_LDA(dst, b, h) do { _Pragma("unroll") for (int m = 0; m < 4; ++m) _Pragma("unroll") for (int k = 0; k < 2; ++k) dst[m][k] = *(const LAS i32x4*)(lds + PG8_SA(b, h) + aoff + m * 2048 + k * 1024); } while (0)
#define PG8_LDB(dst, b, h) do { _Pragma("unroll") for (int n = 0; n < 2; ++n) _Pragma("unroll") for (int k = 0; k < 2; ++k) dst[n][k] = *(const LAS i32x4*)(lds + PG8_SB(b, h) + boff + n * 2048 + k * 1024); } while (0)
#define PG8_CAT(x) __builtin_shufflevector((x)[0], (x)[1], 0, 1, 2, 3, 4, 5, 6, 7)
#define PG8_MMA(ai, bj, At, Bt) do { __builtin_amdgcn_s_setprio(1); _Pragma("unroll") for (int m = 0; m < 4; ++m) _Pragma("unroll") for (int n = 0; n < 2; ++n) \
        acc[ai][bj][m][n] = __builtin_amdgcn_mfma_scale_f32_16x16x128_f8f6f4(PG8_CAT(Bt[n]), PG8_CAT(At[m]), acc[ai][bj][m][n], 0, 0, 0, scaleB, 0, F8_SCALE_ONE); __builtin_amdgcn_s_setprio(0); } while (0)
#define PG8_WAIT_V(n) asm volatile("s_waitcnt vmcnt(" #n ")" ::: "memory")
#define PG8_WAIT_L(n) asm volatile("s_waitcnt lgkmcnt(" #n ")" ::: "memory")
#define PG8_BAR __builtin_amdgcn_s_barrier()
#define PG8_SCHED __builtin_amdgcn_sched_barrier(0)
    Unit cur, nxt; int ui = 0;
    if (!S.next(0, cur)) return;
    Acc acc;
#pragma unroll
    for (int a = 0; a < 2; ++a)
#pragma unroll
        for (int b = 0; b < 2; ++b)
#pragma unroll
            for (int m = 0; m < 4; ++m)
#pragma unroll
                for (int n = 0; n < 2; ++n) acc[a][b][m][n] = (f32x4){0.f, 0.f, 0.f, 0.f};
    i32x4 At[4][2], B0[2][2], B1[2][2];
    unsigned ca[2][2];
    PG8_AOFFS(cur, 0);
    const char* cB = cur.B;
    PG8_STAGEB(PG8_SB(0, 0), cB); PG8_STAGEB(PG8_SB(0, 1), cB + hstep); PG8_STAGEA(PG8_SA(0, 0), 0, ca, 0); PG8_STAGEA(PG8_SA(0, 1), 0, ca, 1);
    if (wr == 1) PG8_BAR;
    PG8_WAIT_V(2); PG8_BAR;
    PG8_STAGEB(PG8_SB(1, 0), cB + kstep); PG8_STAGEA(PG8_SA(1, 0), kstep, ca, 0); PG8_STAGEB(PG8_SB(1, 1), cB + hstep + kstep);
    PG8_WAIT_V(6); PG8_BAR;
    for (;;) {
        const bool has_next = S.next(ui + 1, nxt);
        const char* nB = has_next ? nxt.B : cB;
        Unit un = cur; un.pm = has_next ? nxt.pm : cur.pm; const int uin = has_next ? ui + 1 : ui;
#pragma clang loop unroll(disable)
        for (int t = 0; t < nt; t += 2) {
            const bool last = (t == nt - 2);
            const size_t k1 = (size_t)(t + 1) * kstep;
            const size_t k2 = last ? 0 : (size_t)(t + 2) * kstep, k3 = k2 + kstep;
            const char* b2 = last ? nB : cB + (size_t)(t + 2) * kstep; const char* b3 = b2 + kstep;
            Unit ua = cur; ua.pm = last ? un.pm : cur.pm; const int uia = last ? uin : ui;
            PG8_LDB(B0, 0, 0); PG8_LDB(B1, 0, 1); PG8_SCHED; PG8_LDA(At, 0, 0); PG8_STAGEA(PG8_SA(1, 1), k1, ca, 1);
            PG8_WAIT_V(8); PG8_WAIT_L(0); PG8_BAR; PG8_MMA(0, 0, At, B0); PG8_MMA(0, 1, At, B1); PG8_BAR; PG8_SCHED;
            PG8_AOFFS(ua, uia);
            PG8_LDA(At, 0, 1); PG8_STAGEB(PG8_SB(0, 0), b2); PG8_STAGEB(PG8_SB(0, 1), b2 + hstep); PG8_STAGEA(PG8_SA(0, 0), k2, ca, 0);
            PG8_WAIT_V(8); PG8_WAIT_L(0); PG8_BAR; PG8_MMA(1, 0, At, B0); PG8_MMA(1, 1, At, B1); PG8_BAR; PG8_SCHED;
            PG8_LDB(B0, 1, 0); PG8_LDB(B1, 1, 1); PG8_SCHED; PG8_LDA(At, 1, 0); PG8_STAGEA(PG8_SA(0, 1), k2, ca, 1);
            PG8_WAIT_V(8); PG8_WAIT_L(0); PG8_BAR; PG8_MMA(0, 0, At, B0); PG8_MMA(0, 1, At, B1); PG8_BAR; PG8_SCHED;
            PG8_LDA(At, 1, 1); PG8_STAGEB(PG8_SB(1, 0), b3); PG8_STAGEB(PG8_SB(1, 1), b3 + hstep); PG8_STAGEA(PG8_SA(1, 0), k3, ca, 0);
            PG8_WAIT_V(8); PG8_WAIT_L(0); PG8_BAR; PG8_MMA(1, 0, At, B0); PG8_MMA(1, 1, At, B1); PG8_BAR; PG8_SCHED;
        }
        if (wr == 0) PG8_BAR;
        { const int l_ = lane_now(); E(acc, cur, ui, wr, wc, l_ & 15, l_ >> 4); }
        if (!has_next) break;
#pragma unroll
        for (int a = 0; a < 2; ++a)
#pragma unroll
            for (int b = 0; b < 2; ++b)
#pragma unroll
                for (int m = 0; m < 4; ++m)
#pragma unroll
                    for (int n = 0; n < 2; ++n) acc[a][b][m][n] = (f32x4){0.f, 0.f, 0.f, 0.f};
        cur = nxt; cB = nB; ++ui;
        if (wr == 1) PG8_BAR;
    }
    PG8_WAIT_V(0);
    PG8_BAR;
#undef PG8_SA
#undef PG8_SB
#undef PG8_STAGEA
#undef PG8_STAGEB
#undef PG8_LDA
#undef PG8_LDB
#undef PG8_CAT
#undef PG8_AOFFS
#undef PG8_MMA
#undef PG8_WAIT_V
#undef PG8_WAIT_L
#undef PG8_BAR
#undef PG8_SCHED
}

#define XB_TMO      128
#define XB_XCNT(j)  (256  + 64 * (j))
#define XB_XSUB(j)  (1280 + 64 * (j))
#define XB_XGEN(j)  (2304 + 64 * (j))
#define XB_TOP      3328
#define XB_TOPGEN   3392
#define XCD_BAR_WORDS 3456
#define XB_SPIN_CAP (1u << 18)
__device__ __forceinline__ unsigned xb_ld(unsigned* p)              { return __hip_atomic_load(p, __ATOMIC_RELAXED, __HIP_MEMORY_SCOPE_AGENT); }
__device__ __forceinline__ unsigned xb_add(unsigned* p, unsigned v) { return __hip_atomic_fetch_add(p, v, __ATOMIC_RELAXED, __HIP_MEMORY_SCOPE_AGENT); }
__device__ __forceinline__ unsigned xb_xcc_id() { return (unsigned)__builtin_amdgcn_s_getreg((3 << 11) | 20) & 0xFu; }
#define XB_SPIN(cond, bar) do { unsigned _sp = 0; while (cond) { __builtin_amdgcn_s_sleep(1); \
    if ((++_sp & 255u) == 0u) { if (xb_ld(&(bar)[XB_TMO])) break; if (_sp > XB_SPIN_CAP) { atomicAdd(&(bar)[XB_TMO], 1u); break; } } } } while (0)
struct XcdBarrier { unsigned* bar; unsigned x; volatile LAS unsigned* st; };
__device__ __forceinline__ XcdBarrier xcd_barrier_post(unsigned* bar, volatile LAS unsigned* st) {
    XcdBarrier b; b.bar = bar; b.x = xb_xcc_id(); b.st = st;
    if (threadIdx.x == 0) (void)xb_add(&bar[XB_XCNT(b.x)], 1u);
    return b;
}
#define XB_DONE(j, r) (4096 + 64 * (4 * (j) + (r)))
__device__ __forceinline__ void xcd_barrier_complete(unsigned* bar, unsigned x, unsigned& nloc, unsigned& nx, unsigned& xmask, const int lane) {
    const unsigned G = gridDim.x * gridDim.y * gridDim.z;
    unsigned sum, cnt, mine, sp = 0u; xmask = 0u;
    for (;;) {
        const unsigned c = lane < 16 ? xb_ld(&bar[XB_XCNT(lane)]) : 0u;
        unsigned t = c;
#pragma unroll
        for (int o = 1; o < 16; o <<= 1) t += (unsigned)__builtin_amdgcn_ds_bpermute((lane ^ o) << 2, (int)t);
        sum = (unsigned)__builtin_amdgcn_readfirstlane((int)t);
        xmask = (unsigned)__builtin_amdgcn_ballot_w64(c > 0u) & 0xffffu; cnt = (unsigned)__builtin_popcount(xmask);
        mine = (unsigned)__builtin_amdgcn_readlane((int)c, (int)x);
        if (sum == G) break;
        __builtin_amdgcn_s_sleep(1);
        if ((++sp & 255u) == 0u) { if (xb_ld(&bar[XB_TMO])) break; if (sp > XB_SPIN_CAP) { if (lane == 0) atomicAdd(&bar[XB_TMO], 1u); break; } }
    }
    nloc = mine > 0u ? mine : 1u; nx = cnt > 0u ? cnt : 1u; if (sum != G) xmask = 1u << x;
}
__device__ __forceinline__ void xcd_barrier(const XcdBarrier& b, const bool wave0, const int lane) {
    asm volatile("s_waitcnt vmcnt(0)" ::: "memory");
    __syncthreads();
    if (wave0) {
        unsigned* bar = b.bar;
        __builtin_amdgcn_s_waitcnt(0);
        asm volatile("buffer_inv sc1" ::: "memory");
        unsigned nloc = b.st[0], nx = b.st[1], xmask = b.st[2];
        if (nloc == 0u) { xcd_barrier_complete(bar, b.x, nloc, nx, xmask, lane); if (lane == 0) { b.st[0] = nloc; b.st[1] = nx; b.st[2] = xmask; } }
        unsigned gen = 0u;
        if (lane == 0) {
            const unsigned old = xb_add(&bar[XB_XSUB(b.x)], 1u);
            gen = old / nloc;
            if (old + 1u == (gen + 1u) * nloc) {
                __builtin_amdgcn_fence(__ATOMIC_RELEASE, "agent");
                asm volatile("s_waitcnt vmcnt(0)" ::: "memory");
#pragma unroll
                for (unsigned r = 0; r < 4; ++r) __hip_atomic_store(&bar[XB_DONE(b.x, r)], gen + 1u, __ATOMIC_RELAXED, __HIP_MEMORY_SCOPE_AGENT);
            }
        }
        gen = (unsigned)__builtin_amdgcn_readfirstlane((int)gen);
        const unsigned rep = (blockIdx.x >> 3) & 3u;
        for (unsigned sp = 0u;;) {
            const unsigned v = (lane < 16 && ((xmask >> lane) & 1u)) ? xb_ld(&bar[XB_DONE(lane, rep)]) : 0xffffffffu;
            if (__builtin_amdgcn_ballot_w64(v < gen + 1u) == 0ull) break;
            __builtin_amdgcn_s_sleep(1);
            if ((++sp & 255u) == 0u) { if (xb_ld(&bar[XB_TMO])) break; if (sp > XB_SPIN_CAP) { if (lane == 0) atomicAdd(&bar[XB_TMO], 1u); break; } }
        }
        asm volatile("s_waitcnt vmcnt(0)" ::: "memory");
    }
    __syncthreads();
}

struct Args { const float* in[27]; float* out; unsigned char* ws; int ph_lo, ph_hi, dry, pad; };
typedef float f32x16 __attribute__((ext_vector_type(16)));
typedef short s16x4 __attribute__((ext_vector_type(4)));

__device__ __forceinline__ void tr_item(const float* W, int ldn, int K, int k0, int n0, bf16_t* WT, int orow0, const float* gk, LAS float* scr, int lane, const float f8 = 0.f) {
    float v[32];
    const float* src = W + (size_t)(k0 + (lane >> 5)) * ldn + n0 + (lane & 31);
#pragma unroll
    for (int i = 0; i < 32; ++i) v[i] = __builtin_nontemporal_load(src + (size_t)(2 * i) * ldn);
    const int c = lane & 7;
    f32x4 g0 = (f32x4){1.f, 1.f, 1.f, 1.f}, g1 = g0;
    if (gk) { g0 = *(const f32x4*)(gk + k0 + 8 * c); g1 = *(const f32x4*)(gk + k0 + 8 * c + 4); }
#pragma unroll
    for (int i = 0; i < 32; ++i) scr[(2 * i + (lane >> 5)) * 33 + (lane & 31)] = v[i];
    asm volatile("s_waitcnt lgkmcnt(0)" ::: "memory");
#pragma unroll
    for (int j = 0; j < 4; ++j) { const int n = (lane >> 3) + 8 * j; const LAS float* s = scr + (8 * c) * 33 + n;
        if (f8 != 0.f) { const f32x4 a = (f32x4){s[0 * 33] * g0[0], s[1 * 33] * g0[1], s[2 * 33] * g0[2], s[3 * 33] * g0[3]} * f8, b = (f32x4){s[4 * 33] * g1[0], s[5 * 33] * g1[1], s[6 * 33] * g1[2], s[7 * 33] * g1[3]} * f8;
            *(u32x2*)((unsigned char*)WT + (size_t)(orow0 + n) * K + k0 + 8 * c) = pack8_fp8(a, b); continue; }
        u32x4 o; o.x = pk2(s[0 * 33] * g0[0], s[1 * 33] * g0[1]); o.y = pk2(s[2 * 33] * g0[2], s[3 * 33] * g0[3]); o.z = pk2(s[4 * 33] * g1[0], s[5 * 33] * g1[1]); o.w = pk2(s[6 * 33] * g1[2], s[7 * 33] * g1[3]);
        st16(WT + (size_t)(orow0 + n) * K + k0 + 8 * c, o); }
    asm volatile("s_waitcnt lgkmcnt(0)" ::: "memory");
}
__device__ __forceinline__ void conv_matrix(const float* W, int K, int N, bf16_t* WT, const float* gk, int mode, int item, LAS float* scr, int lane, const float f8 = 0.f) {
    const int nnb = N / 32, kb = item / nnb, nb = item % nnb, k0 = kb * 64, n0 = nb * 32;
    int orow = n0;
    if (mode == 1) orow = 256 * (n0 >> 7) + (n0 & 127);
    else if (mode == 2) orow = 256 * (n0 >> 7) + 128 + (n0 & 127);
    else if (mode == 3) {
        if (n0 >= 2 * D) { const int cc = n0 - 2 * D; orow = 256 * (4 + (cc >> 7)) + 128 + (cc & 127); }
        else if (n0 >= D) { const int cc = n0 - D; orow = 256 * (4 + (cc >> 7)) + (cc & 127); }
    } else if (mode == 4) { const int sg = n0 >> 6; orow = 256 * (sg >> 2) + 128 * ((n0 >> 5) & 1) + 32 * (sg & 3); }
    tr_item(W, N, K, k0, n0, WT, orow, gk, scr, lane, f8);
}
struct CvIt { const float* src; unsigned char* dst; const float* gk; int ldn, K, nt; float f8; };
__device__ __forceinline__ CvIt cv_desc(const float* W, int K, int N, unsigned char* WT, const float* gk, int mode, int item, int lane, int es, float f8) {
    const int nnb = N / 32, kb = item / nnb, nb = item % nnb, k0 = kb * 64, n0 = nb * 32;
    int orow = n0;
    if (mode == 1) orow = 256 * (n0 >> 7) + (n0 & 127);
    else if (mode == 2) orow = 256 * (n0 >> 7) + 128 + (n0 & 127);
    CvIt d; d.src = W + (size_t)(k0 + (lane >> 5)) * N + n0 + (lane & 31); d.dst = WT + ((size_t)orow * K + k0) * es; d.gk = gk ? gk + k0 : nullptr; d.ldn = N; d.K = K; d.nt = 0; d.f8 = f8; return d;
}
constexpr int IT_LAYER = 24576, IT_GU = 16384, IT_DN = 8192;
__device__ __forceinline__ CvIt cv_expert(const float* wg, const float* wu, const float* wdn, const float* gffn, unsigned char* ws, int it, int lane, int nt) {
    const int layer = it / IT_LAYER, q = it % IT_LAYER;
    const int e = q < IT_GU ? q / 512 : (q - IT_GU) / 256, r = q < IT_GU ? q % 512 : 512 + (q - IT_GU) % 256;
    const int es = 1;
    unsigned char* wgu = ws + WS_WGU + (size_t)layer * WS_MOE_LAYER + (size_t)e * D * D * es;
    unsigned char* wd = ws + WS_WD + (size_t)layer * WS_MOE_LAYER + (size_t)e * D * DE * es;
    const size_t eoff = ((size_t)layer * NE + e) * D * DE;
    CvIt d = r < 256 ? cv_desc(wg + eoff, D, DE, wgu, gffn + layer * D, 1, r, lane, es, 32.f) : (r < 512 ? cv_desc(wu + eoff, D, DE, wgu, gffn + layer * D, 2, r - 256, lane, es, 32.f) : cv_desc(wdn + eoff, DE, D, wd, nullptr, 0, r - 512, lane, es, 16.f));
    d.nt = nt; return d;
}
__device__ __forceinline__ void cv_load(const CvIt& d, float (&v)[32], f32x4& g0, f32x4& g1, int lane) {
#pragma unroll
    for (int i = 0; i < 32; ++i) v[i] = __builtin_nontemporal_load(d.src + (size_t)(2 * i) * d.ldn);
    g0 = (f32x4){1.f, 1.f, 1.f, 1.f}; g1 = g0;
    if (d.gk) { g0 = *(const f32x4*)(d.gk + 8 * (lane & 7)); g1 = *(const f32x4*)(d.gk + 8 * (lane & 7) + 4); }
}
__device__ __forceinline__ void cv_store(const CvIt& d, const float (&v)[32], const f32x4 g0, const f32x4 g1, LAS float* scr, int lane) {
#pragma unroll
    for (int i = 0; i < 32; ++i) scr[(2 * i + (lane >> 5)) * 33 + (lane & 31)] = v[i];
    asm volatile("s_waitcnt lgkmcnt(0)" ::: "memory");
    const int c = lane & 7;
#pragma unroll
    for (int j = 0; j < 4; ++j) { const int n = (lane >> 3) + 8 * j; const LAS float* s = scr + (8 * c) * 33 + n;
        if (d.f8 != 0.f) { const f32x4 a = (f32x4){s[0 * 33] * g0[0], s[1 * 33] * g0[1], s[2 * 33] * g0[2], s[3 * 33] * g0[3]} * d.f8, b = (f32x4){s[4 * 33] * g1[0], s[5 * 33] * g1[1], s[6 * 33] * g1[2], s[7 * 33] * g1[3]} * d.f8;
            const u32x2 o8 = pack8_fp8(a, b); if (d.nt) __builtin_nontemporal_store(o8, (u32x2*)(d.dst + (size_t)n * d.K + 8 * c)); else *(u32x2*)(d.dst + (size_t)n * d.K + 8 * c) = o8; continue; }
        u32x4 o; o.x = pk2(s[0 * 33] * g0[0], s[1 * 33] * g0[1]); o.y = pk2(s[2 * 33] * g0[2], s[3 * 33] * g0[3]); o.z = pk2(s[4 * 33] * g1[0], s[5 * 33] * g1[1]); o.w = pk2(s[6 * 33] * g1[2], s[7 * 33] * g1[3]);
        if (d.nt) __builtin_nontemporal_store(o, (u32x4*)(d.dst + ((size_t)n * d.K + 8 * c) * 2)); else st16((bf16_t*)(d.dst + ((size_t)n * d.K + 8 * c) * 2), o); }
    asm volatile("s_waitcnt lgkmcnt(0)" ::: "memory");
}
__device__ __forceinline__ void cpow(float lre, float lim, float step, float n, float& wr, float& wi) {
    const float er = expf(n * lre * step), ang = n * lim * step; wr = er * cosf(ang); wi = er * sinf(ang);
}
__device__ __forceinline__ f32x4 mfma16(bf16x8 a, bf16x8 b, f32x4 c) { return __builtin_amdgcn_mfma_f32_16x16x32_bf16(a, b, c, 0, 0, 0); }
__device__ __forceinline__ f32x16 mfma32(bf16x8 a, bf16x8 b, f32x16 c) { return __builtin_amdgcn_mfma_f32_32x32x16_bf16(a, b, c, 0, 0, 0); }
__device__ __forceinline__ s16x4 vtr(LAS unsigned char* p) { return __builtin_bit_cast(s16x4, __builtin_amdgcn_ds_read_tr16_b64_v4i16((LAS s16x4*)p)); }

__global__ void __launch_bounds__(512, 2) fwd(Args args) {
    extern __shared__ __attribute__((aligned(16))) unsigned char lds_raw[];
    LAS unsigned char* lds = (LAS unsigned char*)lds_raw;
    const int G = gridDim.x, bx = blockIdx.x, NGW = G * 8;
    volatile LAS unsigned* MISC = (volatile LAS unsigned*)(lds + MISC_OFF);
    if (threadIdx.x < 64) MISC[threadIdx.x] = 0u;
    __syncthreads();
    XcdBarrier bar; bar.bar = (unsigned*)(args.ws + WS_CTL) + CW_BAR; bar.x = 0; bar.st = nullptr;
    if (NLAUNCH == 1) bar = xcd_barrier_post((unsigned*)(args.ws + WS_CTL) + CW_BAR, MISC);
    const int lo = args.ph_lo, hi = args.ph_hi;
    const int wv0 = __builtin_amdgcn_readfirstlane(threadIdx.x >> 6);
#define IN(k) (lo <= (k) && (k) < hi)
#define SEAM(k) do { if (NLAUNCH == 1 && IN((k) + 1)) xcd_barrier(bar, wv0 == 0, lane_now()); } while (0)
#define PH_ENTER \
    int tid = wv0 * 64 + lane_now(); \
    const int lane = tid & 63, wave = __builtin_amdgcn_readfirstlane(tid >> 6), gw = bx * 8 + wave; \
    GAS_U8* wsg_ = (GAS_U8*)args.ws; asm volatile("" : "+s"(wsg_)); unsigned char* ws = (unsigned char*)wsg_;            \
    GAS_F32* houtg_ = (GAS_F32*)args.out; asm volatile("" : "+s"(houtg_)); float* hout = (float*)houtg_; \
    unsigned* ctl = (unsigned*)(ws + WS_CTL); (void)ctl; (void)lane; (void)gw; \
    float* rs_mix = (float*)(ws + WS_RSMIX); float* rs_ffn = (float*)(ws + WS_RSFFN); (void)rs_mix; (void)rs_ffn; \
    int* tokrow = (int*)(ws + WS_TOKROW); int* list = (int*)(ws + WS_LIST); float* gatel = (float*)(ws + WS_GATEL); (void)tokrow; (void)list; (void)gatel; \
    bf16_t* hb = (bf16_t*)(ws + WS_HB); (void)hb; \
    bf16_t* proj = (bf16_t*)(ws + WS_PROJ); bf16_t* concat = (bf16_t*)(ws + WS_CONCAT); bf16_t* yssm = (bf16_t*)(ws + WS_YSSM); (void)proj; (void)concat; (void)yssm; \
    bf16_t* bgate = (bf16_t*)(ws + WS_BGATE); bf16_t* zcb = (bf16_t*)(ws + WS_ZC); bf16_t* g2b = (bf16_t*)(ws + WS_G2); (void)bgate; (void)zcb; (void)g2b; \
    bf16_t* Hb = (bf16_t*)(ws + WS_H); bf16_t* Yb = (bf16_t*)(ws + WS_Y); (void)Hb; (void)Yb;

    if (IN(PH_PRO)) { PH_ENTER
        const float* x = args.in[0];
        LAS float* scr = (LAS float*)(lds + wave * 16384);
        constexpr int I_IN0 = 16 * 56, I_GLU = 10 * 20, I_O0 = 16 * 32, I_INC = 16 * 96, I_OC = 16 * 32, I_DENSE = I_IN0 + I_GLU + I_O0 + I_INC + I_OC;
        constexpr int I_EXP = 768, NITEMS = I_DENSE + NE * I_EXP;
#define EXPERT_ITEMS(gw_, ngw_, first_, last_, nt_) do { for (int it_ = (first_) + (gw_); it_ < (last_); it_ += 2 * (ngw_)) { \
            const bool hb_ = it_ + (ngw_) < (last_); \
            const CvIt da_ = cv_expert(args.in[24], args.in[25], args.in[26], args.in[2], ws, it_, lane, nt_), db_ = cv_expert(args.in[24], args.in[25], args.in[26], args.in[2], ws, hb_ ? it_ + (ngw_) : it_, lane, nt_); \
            float va_[32], vb_[32]; f32x4 ga0_, ga1_, gb0_, gb1_; \
            cv_load(da_, va_, ga0_, ga1_, lane); cv_load(db_, vb_, gb0_, gb1_, lane);            \
            cv_store(da_, va_, ga0_, ga1_, scr, lane); if (hb_) cv_store(db_, vb_, gb0_, gb1_, scr, lane); } } while (0)
#define DENSE_ITEMS(gw_, ngw_, first_, last_) do { for (int it_ = (first_) + (gw_); it_ < (last_); it_ += (ngw_)) { int r_ = it_; \
            if (r_ < 896) { conv_matrix(args.in[3], D, MIXIN, (bf16_t*)(ws + WS_WIN0), args.in[1], 4, r_, scr, lane); continue; } r_ -= 896; \
            if (r_ < 200) { conv_matrix(args.in[12], SSMW, SSMW, (bf16_t*)(ws + WS_WGLU), nullptr, 0, r_, scr, lane); continue; } r_ -= 200; \
            if (r_ < 512) { conv_matrix(args.in[16], D, D, (bf16_t*)(ws + WS_WOUT0), nullptr, 0, r_, scr, lane); continue; } r_ -= 512; \
            if (r_ < 1536) { conv_matrix(args.in[17], D, CONVN, (bf16_t*)(ws + WS_WINC), args.in[1] + D, 3, r_, scr, lane); continue; } r_ -= 1536; \
            conv_matrix(args.in[19], D, D, (bf16_t*)(ws + WS_WOUTC), nullptr, 0, r_, scr, lane, 32.f); } } while (0)
        static_assert(I_IN0 == 896 && I_GLU == 200 && I_O0 == 512 && I_INC == 1536 && I_OC == 512, "dense item list");
        DENSE_ITEMS(NGW - 1 - gw, NGW, 0, 896);
        const int nheavy = (NG * 8 > G && NG * 8 < 2 * G) ? NG * 8 - G : 0, nl = G - nheavy, lw = bx - nheavy;
        (void)NITEMS;
        { u32x4* z = (u32x4*)((bf16_t*)(ws + WS_WGLU) + (size_t)SSMW * SSMW); const int n16 = (GLUN - SSMW) * SSMW * 2 / 16;
          for (int i = bx * 512 + tid; i < n16; i += G * 512) z[i] = (u32x4){0u, 0u, 0u, 0u}; }
        { bf16_t* wrt = (bf16_t*)(ws + WS_WRT);
          if (lw >= 0) for (int i = lw * 512 + tid; i < 2 * 48 * D; i += nl * 512) { const int layer = i / (48 * D), n = (i / D) % 48, k = i % D;
              float v = 0.f;
              if (n < 4) v = args.in[20][((size_t)layer * D + k) * 4 + n]; else if (n < 36) v = args.in[22][((size_t)layer * D + k) * NE + (n - 4)];
              v *= args.in[2][layer * D + k];
              const unsigned hi = f2bf(v); const float rem = v - __uint_as_float(hi << 16);
              wrt[(size_t)layer * 2 * 48 * D + (size_t)n * D + k] = (bf16_t)hi; wrt[(size_t)layer * 2 * 48 * D + 48 * D + (size_t)n * D + k] = (bf16_t)f2bf(rem); } }
        {
            const float* a_re = args.in[4]; const float* a_im = args.in[5]; const float* b_re = args.in[6]; const float* b_im = args.in[7];
            const float* c_re = args.in[8]; const float* c_im = args.in[9]; const float* logstep = args.in[11];
            float* Lam = (float*)(ws + WS_LAM); bf16_t* Kf = (bf16_t*)(ws + WS_KF); bf16_t* Ct = (bf16_t*)(ws + WS_CT); bf16_t* Bend = (bf16_t*)(ws + WS_BEND);
            if (lw >= 0) for (int i = lw * 512 + tid; i < NG * 64 * NS; i += nl * 512) { const int g = i / (64 * NS), t = (i / NS) % 64, p = i % NS;
                float wr_, wi_; cpow(a_re[g * NS + p], a_im[g * NS + p], expf(logstep[g]), (float)(t + 1), wr_, wi_);
                const int rt = t >> 4, row = t & 15, kc = p >> 4, kq = (p >> 2) & 3, half = (p >> 1) & 1, q = p & 1;
                float* o = Lam + ((((size_t)(g * 4 + rt) * 4 + kc) * 2 + half) * 64 + kq * 16 + row) * 4 + 2 * q; o[0] = wr_; o[1] = wi_; }
            if (lw >= 0) for (int i = lw * 512 + tid; i < NG * NS * 64; i += nl * 512) { const int g = i / (NS * 64), p = (i / 64) % NS, j = i % 64;
                const float lre = a_re[g * NS + p], lim = a_im[g * NS + p], step = expf(logstep[g]);
                float l1r, l1i; cpow(lre, lim, step, 1.f, l1r, l1i);
                const float nr = l1r - 1.f, ni = l1i, den = lre * lre + lim * lim, fr_ = (nr * lre + ni * lim) / den, fi_ = (ni * lre - nr * lim) / den;
                float wr_, wi_; cpow(lre, lim, step, (float)(63 - j), wr_, wi_);
                const float gr = wr_ * fr_ - wi_ * fi_, gi = wr_ * fi_ + wi_ * fr_;
                unsigned zr[8], zi[8];
#pragma unroll
                for (int h2 = 0; h2 < 8; ++h2) { float re[2], im[2];
#pragma unroll
                    for (int q = 0; q < 2; ++q) { const float xr = b_re[((size_t)g * NS + p) * GS + 2 * h2 + q], xi = b_im[((size_t)g * NS + p) * GS + 2 * h2 + q]; re[q] = gr * xr - gi * xi; im[q] = gr * xi + gi * xr; }
                    zr[h2] = pk2(re[0], re[1]); zi[h2] = pk2(im[0], im[1]); }
                u32x4* o0 = (u32x4*)(Bend + ((size_t)g * 128 + 2 * p) * 1024 + j * 16); u32x4* o1 = (u32x4*)(Bend + ((size_t)g * 128 + 2 * p + 1) * 1024 + j * 16);
                o0[0] = (u32x4){zr[0], zr[1], zr[2], zr[3]}; o0[1] = (u32x4){zr[4], zr[5], zr[6], zr[7]};
                o1[0] = (u32x4){zi[0], zi[1], zi[2], zi[3]}; o1[1] = (u32x4){zi[4], zi[5], zi[6], zi[7]}; }
            if (lw >= 0) for (int i = lw * 512 + tid; i < NG * GS * NS; i += nl * 512) { const int g = i / (GS * NS), h = (i / NS) % GS, p = i % NS;
                const int k = 2 * p, kc = k >> 5, kq = (k >> 3) & 3, j = k & 7;
                *(unsigned*)(Ct + (((size_t)g * 4 + kc) * 64 + kq * 16 + h) * 8 + j) = pk2(c_re[i], -c_im[i]); }
            {
                LAS float* cL = (LAS float*)lds;
                LAS float* bL = cL + 2048;
                LAS float* fw = bL + 2048 + wave * 128;
                int gl = -1;
                for (int task = bx; task < NG * 8; task += G) { const int g = task >> 3, tau = (task & 7) * 8 + wave;
                    if (g != gl) { gl = g; __syncthreads();
                        for (int i = tid; i < GS * NS; i += 512) { cL[2 * i] = c_re[(size_t)g * GS * NS + i]; cL[2 * i + 1] = c_im[(size_t)g * GS * NS + i]; bL[2 * i] = b_re[(size_t)g * NS * GS + i]; bL[2 * i + 1] = b_im[(size_t)g * NS * GS + i]; }
                        __syncthreads(); }
                    { const int p = lane; const float lre = a_re[g * NS + p], lim = a_im[g * NS + p], step = expf(logstep[g]);
                      float l1r, l1i; cpow(lre, lim, step, 1.f, l1r, l1i);
                      const float nr = l1r - 1.f, ni = l1i, den = lre * lre + lim * lim, fr_ = (nr * lre + ni * lim) / den, fi_ = (ni * lre - nr * lim) / den;
                      float wr_, wi_; cpow(lre, lim, step, (float)tau, wr_, wi_);
                      fw[2 * p] = wr_ * fr_ - wi_ * fi_; fw[2 * p + 1] = wr_ * fi_ + wi_ * fr_; }
                    asm volatile("s_waitcnt lgkmcnt(0)" ::: "memory"); __builtin_amdgcn_wave_barrier();
                    const int h = lane >> 2, hq = (lane & 3) * 4; float acc4[4] = {0.f, 0.f, 0.f, 0.f};
#pragma unroll 4
                    for (int p = 0; p < NS; ++p) { const float fr_ = fw[2 * p], fi_ = fw[2 * p + 1];
                        const float cr = cL[2 * (h * NS + p)], ci = cL[2 * (h * NS + p) + 1];
                        const float er = cr * fr_ - ci * fi_, ei = cr * fi_ + ci * fr_;
#pragma unroll
                        for (int q = 0; q < 4; ++q) acc4[q] += er * bL[2 * (p * GS + hq + q)] - ei * bL[2 * (p * GS + hq + q) + 1]; }
                    { const int ks = tau >> 1, kq2 = 2 * (tau & 1) + (hq >> 3), j = hq & 7;
                      *(u32x2*)(Kf + (((size_t)g * 32 + ks) * 64 + kq2 * 16 + h) * 8 + j) = (u32x2){pk2(acc4[0], acc4[1]), pk2(acc4[2], acc4[3])}; }
                    asm volatile("s_waitcnt lgkmcnt(0)" ::: "memory"); __builtin_amdgcn_wave_barrier();
                }
            }
        }
        for (int m0 = gw; m0 < T; m0 += 4 * NGW) {
            f32x4 v[4][4];
#pragma unroll
            for (int q = 0; q < 4; ++q) { const int mq = m0 + q * NGW, mc = mq < T ? mq : m0; const f32x4* xr = (const f32x4*)(x + (size_t)mc * D) + lane;
#pragma unroll
                for (int j = 0; j < 4; ++j) v[q][j] = __builtin_nontemporal_load(xr + 64 * j); }
#pragma unroll
            for (int q = 0; q < 4; ++q) { const int m = m0 + q * NGW; if (m >= T) break;
                float s = 0.f;
#pragma unroll
                for (int j = 0; j < 4; ++j) s += (v[q][j].x * v[q][j].x + v[q][j].y * v[q][j].y) + (v[q][j].z * v[q][j].z + v[q][j].w * v[q][j].w);
                s = wave_sum(s);
                if (lane == 0) rs_mix[m] = rsqrtf(s * (1.f / D) + EPS);
                u32x2* o8 = (u32x2*)(hb + (size_t)m * D) + lane;
#pragma unroll
                for (int j = 0; j < 4; ++j) o8[64 * j] = (u32x2){cvt_pk_bf16(v[q][j].x, v[q][j].y), cvt_pk_bf16(v[q][j].z, v[q][j].w)}; }
        }
        SEAM(PH_PRO);
    }

    if (IN(PH_INPROJ)) { PH_ENTER
        SchedPlain Sd{T / BM, MIXIN / BM, G, bx, D, (const char*)(ws + WS_WIN0), 2};
        EpiProj E{proj, (bf16_t*)(ws + WS_UG), rs_mix, args.in[14], args.in[15]};
        gemm_phase<EpiProj, SchedPlain, true, true>(lds, tid, (const char*)hb, D, Sd, E);
        { constexpr int I_EXP = 768; LAS float* scr = (LAS float*)(lds + wave * 16384); const int r = ((T / BM) * (MIXIN / BM)) % G;
          __syncthreads();
          if (r == 0) { DENSE_ITEMS(gw, NGW, 896, 1096); EXPERT_ITEMS(gw, NGW, IT_GU - FILL_IN - FILL_GLU, IT_GU - FILL_GLU, 0); }
          else if (bx >= r) { DENSE_ITEMS((bx - r) * 8 + wave, (G - r) * 8, 896, 1096); EXPERT_ITEMS((bx - r) * 8 + wave, (G - r) * 8, IT_GU - FILL_IN - FILL_GLU, IT_GU - FILL_GLU, 0); } }
        SEAM(PH_INPROJ);
    }

    if (IN(PH_ATTN)) { PH_ENTER
        const bool split_sa = G >= 4 * NG;
        if (!DRY_MASK || args.dry != 3) {
            SchedSsm Sd{split_sa ? G : NG, bx, (const char*)(ws + WS_BEND)};
            EpiSend E{(float*)(ws + WS_SEND)};
            gemm_phase<EpiSend, SchedSsm, true, true>(lds, tid, (const char*)(ws + WS_UG), 1024, Sd, E);
        }
        if (!DRY_MASK || args.dry != 2) {
            bf16_t* opart = (bf16_t*)(ws + WS_OPART); float* mpart = (float*)(ws + WS_MPART); float* lpart = (float*)(ws + WS_LPART);
            constexpr int KST = 144, VST = 192, VOFF = 384 * KST;
            const int r32 = lane & 31, hh = lane >> 5;
            u32x4 pk[6], pv[6];
#define ATT_DECODE(unit_) const int pat = (unit_) / 384, rem = (unit_) % 384, bh = rem % 12, b = bh / AH, h = bh % AH, rq = rem / 12; \
                const int dil = pat == 0 ? 1 : (pat == 1 ? 4 : 16), nqb = 32 / dil, res = rq / nqb, qb = rq % nqb; \
                const bf16_t* base = proj + (size_t)(b * S + res) * MIXIN + h * HD; const size_t tstride = (size_t)dil * MIXIN; const int i0 = 256 * qb - 128;
#define ATT_LOAD(unit_) do { ATT_DECODE(unit_) (void)h; \
                _Pragma("unroll") for (int j = 0; j < 6; ++j) { const int ch = tid + 512 * j, rho = ch >> 3, c16 = ch & 7, i = i0 + rho; const bf16_t* rp = base + (size_t)(i < 0 ? 0 : i) * tstride + SSMW + AW + c16 * 8; \
                    pk[j] = *(const u32x4*)rp; pv[j] = *(const u32x4*)(rp + AW); } } while (0)
            const int GA = split_sa ? G - NG : G, NU5 = (split_sa && 5 * GA < 3 * 384) ? 5 * GA : 3 * 384;
            const int u_first = bx < GA ? bx : NU5 + (bx - GA), u_step = bx < GA ? GA : NG, u_end = bx < GA ? NU5 : 3 * 384;
            if (u_first < u_end) ATT_LOAD(u_first);
            for (int unit = u_first; unit < u_end; unit += u_step) {
                ATT_DECODE(unit)
                const int iq = 256 * qb + 32 * wave + r32;
                bf16x8 qf[4];
#pragma unroll
                for (int s = 0; s < 4; ++s) qf[s] = *(const bf16x8*)(base + (size_t)iq * tstride + SSMW + 16 * s + 8 * hh);
                __syncthreads();
                { int tl = tid; asm volatile("" : "+v"(tl));
#pragma unroll
                for (int j = 0; j < 6; ++j) { const int ch = tl + 512 * j, rho = ch >> 3, c16 = ch & 7;
                    *(LAS u32x4*)(lds + rho * KST + c16 * 16) = pk[j]; *(LAS u32x4*)(lds + VOFF + rho * VST + c16 * 16) = pv[j]; } }
                __syncthreads();
                const float slope2 = exp2f(-8.0f * (h + 1) / AH) * (float)dil * 1.4426950408889634f;
                f32x16 sc[5];
                const LAS unsigned char* kb = lds + (32 * wave + r32) * KST + hh * 16;
#pragma unroll
                for (int kt = 0; kt < 5; ++kt) {
                    f32x16 a = (f32x16){0.f, 0.f, 0.f, 0.f, 0.f, 0.f, 0.f, 0.f, 0.f, 0.f, 0.f, 0.f, 0.f, 0.f, 0.f, 0.f};
#pragma unroll
                    for (int s = 0; s < 4; ++s) a = mfma32(*(const LAS bf16x8*)(kb + kt * 32 * KST + s * 32), qf[s], a);
                    sc[kt] = a;
                }
                if (unit + u_step < u_end) ATT_LOAD(unit + u_step);
                float loff = (float)(r32 - 4 * hh); asm volatile("" : "+v"(loff));
                const float dhalf = 0.5f * (float)(iq < 128 ? iq : 128);
                float mx = -INFINITY;
#pragma unroll
                for (int kt = 0; kt < 5; ++kt)
#pragma unroll
                    for (int r = 0; r < 16; ++r) { const float diff = loff + (float)(128 - 32 * kt - ((r & 3) + 8 * (r >> 2)));
                        float v = sc[kt][r] - slope2 * diff;
                        if (kt == 0 || kt == 4 || qb == 0) v = (fabsf(diff - dhalf) <= dhalf) ? v : -INFINITY;
                        sc[kt][r] = v; mx = fmaxf(mx, v); }
                mx = fmaxf(mx, __shfl_xor(mx, 32));
                float l = 0.f;
#pragma unroll
                for (int kt = 0; kt < 5; ++kt)
#pragma unroll
                    for (int r = 0; r < 16; ++r) { const float e = __builtin_amdgcn_exp2f(sc[kt][r] - mx); sc[kt][r] = e; l += e; }
                l += __shfl_xor(l, 32);
                f32x16 o[2];
#pragma unroll
                for (int dt = 0; dt < 2; ++dt) o[dt] = (f32x16){0.f, 0.f, 0.f, 0.f, 0.f, 0.f, 0.f, 0.f, 0.f, 0.f, 0.f, 0.f, 0.f, 0.f, 0.f, 0.f};
                const int G4 = lane >> 4, q4 = (lane & 15) >> 2, p4 = lane & 3;
                LAS unsigned char* vb = lds + VOFF + (32 * wave + 4 * (G4 >> 1) + q4) * VST + (16 * (G4 & 1) + 4 * p4) * 2;
#pragma unroll
                for (int kt = 0; kt < 5; ++kt)
#pragma unroll
                    for (int s2 = 0; s2 < 2; ++s2) {
                        const bf16x8 pfv = __builtin_bit_cast(bf16x8, (u32x4){cvt_pk_bf16(sc[kt][8 * s2 + 0], sc[kt][8 * s2 + 1]), cvt_pk_bf16(sc[kt][8 * s2 + 2], sc[kt][8 * s2 + 3]),
                                                                               cvt_pk_bf16(sc[kt][8 * s2 + 4], sc[kt][8 * s2 + 5]), cvt_pk_bf16(sc[kt][8 * s2 + 6], sc[kt][8 * s2 + 7])});
#pragma unroll
                        for (int dt = 0; dt < 2; ++dt) {
                            const s16x4 lo4 = vtr(vb + (kt * 32 + s2 * 16) * VST + dt * 64), hi4 = vtr(vb + (kt * 32 + s2 * 16 + 8) * VST + dt * 64);
                            const bf16x8 vf = (bf16x8){lo4[0], lo4[1], lo4[2], lo4[3], hi4[0], hi4[1], hi4[2], hi4[3]};
                            o[dt] = mfma32(vf, pfv, o[dt]); }
                    }
                const float rl = 1.f / l;
                const size_t tok = (size_t)(b * S + res) + (size_t)iq * dil;
                bf16_t* op = opart + ((size_t)pat * T + tok) * AW + h * HD;
#pragma unroll
                for (int dt = 0; dt < 2; ++dt)
#pragma unroll
                    for (int r4 = 0; r4 < 4; ++r4) *(u32x2*)(op + 32 * dt + 8 * r4 + 4 * hh) = (u32x2){cvt_pk_bf16(o[dt][4 * r4] * rl, o[dt][4 * r4 + 1] * rl), cvt_pk_bf16(o[dt][4 * r4 + 2] * rl, o[dt][4 * r4 + 3] * rl)};
                if (hh == 0) { mpart[((size_t)pat * T + tok) * AH + h] = mx; lpart[((size_t)pat * T + tok) * AH + h] = l; }
            }
            __syncthreads();
#undef ATT_DECODE
#undef ATT_LOAD
        }
#if DBG == 2
        {
            bf16_t* dbg = (bf16_t*)(ws + WS_DBGA);
            LAS float* scn = (LAS float*)(lds + 65536 + wave * 2048);
            for (int gi = gw; gi < T * AH; gi += NGW) {
                const int tg = gi / AH, h = gi % AH, b = tg / S, t = tg % S;
                const float slope = exp2f(-8.0f * (h + 1) / AH);
                const float q = bf2f(proj[(size_t)tg * MIXIN + SSMW + h * HD + lane]);
                const bf16_t* Kb = proj + (size_t)b * S * MIXIN + SSMW + AW + h * HD;
                const bf16_t* Vb = proj + (size_t)b * S * MIXIN + SSMW + 2 * AW + h * HD;
                for (int idx = 0; idx < 387; ++idx) { const int pp = idx / 129, j = idx % 129, dil = pp == 0 ? 1 : (pp == 1 ? 4 : 16), tk = t - j * dil;
                    float s = -INFINITY;
                    if (tk >= 0) s = wave_sum(q * bf2f(Kb[(size_t)tk * MIXIN + lane])) - slope * 1.4426950408889634f * (float)(j * dil);
                    if (lane == 0) scn[idx] = s; }
                asm volatile("s_waitcnt lgkmcnt(0)" ::: "memory"); __builtin_amdgcn_wave_barrier();
                float m = -INFINITY;
                for (int idx = lane; idx < 387; idx += 64) m = fmaxf(m, scn[idx]);
                m = wave_max(m);
                float l = 0.f;
                for (int idx = lane; idx < 387; idx += 64) { const float s = scn[idx]; const float e = (s == -INFINITY) ? 0.f : exp2f(s - m); scn[idx] = e; l += e; }
                l = wave_sum(l);
                asm volatile("s_waitcnt lgkmcnt(0)" ::: "memory"); __builtin_amdgcn_wave_barrier();
                float o = 0.f;
                for (int idx = 0; idx < 387; ++idx) { const int pp = idx / 129, j = idx % 129, dil = pp == 0 ? 1 : (pp == 1 ? 4 : 16), tk = t - j * dil;
                    if (tk >= 0) o += scn[idx] * bf2f(Vb[(size_t)tk * MIXIN + lane]); }
                dbg[(size_t)tg * AW + h * HD + lane] = (bf16_t)f2bf(o / l);
                asm volatile("s_waitcnt lgkmcnt(0)" ::: "memory"); __builtin_amdgcn_wave_barrier();
            }
        }
#endif
        SEAM(PH_ATTN);
    }


    if (IN(PH_SSMY)) { PH_ENTER
        const bf16_t* Kf = (const bf16_t*)(ws + WS_KF); const bf16_t* Ct = (const bf16_t*)(ws + WS_CT); const float* Lam = (const float*)(ws + WS_LAM);
        const float* send = (const float*)(ws + WS_SEND); const float* dsk = args.in[10];
        const int row = lane & 15, kq = lane >> 4;
        LAS float* sinL = (LAS float*)(lds + 102400);
        float csr = 0.f, csi = 0.f, cwr = 0.f, cwi = 0.f; int sc_gb = -1, sc_c = 0;
        LAS unsigned char* Uw = lds + 69632 + wave * 4096;
        *(LAS u32x4*)(Uw + lane * 32) = (u32x4){0u, 0u, 0u, 0u}; *(LAS u32x4*)(Uw + lane * 32 + 16) = (u32x4){0u, 0u, 0u, 0u};
        int gcur = -1;
        const int NU = NB * NG * 16, per = (NU + G - 1) / G;
        const int u_end = (bx + 1) * per < NU ? (bx + 1) * per : NU;
        u32x4 nv0, nv1;
#define SSM_LOAD(u_) do { const int g_ = (u_) / 32, b_ = ((u_) >> 4) & 1, c_ = ((u_) & 15) * 8 + wave; \
            const bf16_t* up_ = (const bf16_t*)(ws + WS_UG) + ((size_t)(g_ * NB + b_) * S + c_ * 64) * GS + lane * 8; nv0 = *(const u32x4*)up_; nv1 = *(const u32x4*)(up_ + 512); } while (0)
        if (bx * per < u_end) SSM_LOAD(bx * per);
        for (int u = bx * per; u < u_end; ++u) { const int g = u / 32, b = (u >> 4) & 1, cb = u & 15;
            if (g != gcur) { gcur = g; __syncthreads();
                const u32x4* s0 = (const u32x4*)(Kf + (size_t)g * 32 * 64 * 8); const u32x4* s1 = (const u32x4*)(Ct + (size_t)g * 4 * 64 * 8); const u32x4* s2 = (const u32x4*)(Lam + (size_t)g * 4 * 4 * 2 * 64 * 4);
                u32x4 t0_[4], t2_[4], t1_;
#pragma unroll
                for (int i = 0; i < 4; ++i) { t0_[i] = s0[tid + 512 * i]; t2_[i] = s2[tid + 512 * i]; }
                t1_ = s1[tid & 255];
#pragma unroll
                for (int i = 0; i < 4; ++i) { *(LAS u32x4*)(lds + (tid + 512 * i) * 16) = t0_[i]; *(LAS u32x4*)(lds + 36864 + (tid + 512 * i) * 16) = t2_[i]; }
                if (tid < 256) *(LAS u32x4*)(lds + 32768 + tid * 16) = t1_;
                __syncthreads(); }
            const int c = cb * 8 + wave, t0 = b * S + c * 64;
            *(LAS u32x4*)(Uw + 2048 + lane * 16) = nv0; *(LAS u32x4*)(Uw + 2048 + 1024 + lane * 16) = nv1;
            if (u + 1 < u_end) SSM_LOAD(u + 1);
            LAS float* sL = sinL + ((u & 1) ? 1024 : 0);
            if (wave == 0) {
                if (g * NB + b != sc_gb) { sc_gb = g * NB + b; sc_c = 0; csr = 0.f; csi = 0.f; cpow(args.in[4][g * NS + lane], args.in[5][g * NS + lane], expf(args.in[11][g]), 64.f, cwr, cwi); }
                const float* sp = send + ((size_t)(b * NG + g) * 128) * 128 + 2 * lane;
                for (; sc_c < 8 * cb; sc_c += 8) { float2 e[8];
#pragma unroll
                    for (int j = 0; j < 8; ++j) e[j] = *(const float2*)(sp + (size_t)(sc_c + j) * 128);
#pragma unroll
                    for (int j = 0; j < 8; ++j) { const float nr = cwr * csr - cwi * csi + e[j].x, ni = cwr * csi + cwi * csr + e[j].y; csr = nr; csi = ni; } }
                { float2 e[8];
#pragma unroll
                  for (int j = 0; j < 8; ++j) e[j] = *(const float2*)(sp + (size_t)(8 * cb + j) * 128);
#pragma unroll
                  for (int j = 0; j < 8; ++j) { sL[j * 128 + 2 * lane] = csr; sL[j * 128 + 2 * lane + 1] = csi;
                      const float nr = cwr * csr - cwi * csi + e[j].x, ni = cwr * csi + cwi * csr + e[j].y; csr = nr; csi = ni; }
                  sc_c = 8 * cb + 8; }
            }
            __syncthreads();
            f32x4 sv[4][2];
#pragma unroll
            for (int kc = 0; kc < 4; ++kc) { sv[kc][0] = *(const LAS f32x4*)(sL + wave * 128 + 32 * kc + 8 * kq); sv[kc][1] = *(const LAS f32x4*)(sL + wave * 128 + 32 * kc + 8 * kq + 4); }
            asm volatile("s_waitcnt lgkmcnt(0)" ::: "memory"); __builtin_amdgcn_wave_barrier();
            f32x4 acc[4];
#pragma unroll
            for (int rt = 0; rt < 4; ++rt) acc[rt] = (f32x4){0.f, 0.f, 0.f, 0.f};
            const LAS unsigned char* ua = Uw + (64 + row - (kq >> 1)) * 32 + (kq & 1) * 16;
#pragma unroll
            for (int kb = 0; kb < 4; ++kb)
#pragma unroll
                for (int k8 = 0; k8 < 8; ++k8) { const int ks = 8 * kb + k8;
                    const bf16x8 bfr = *(const LAS bf16x8*)(lds + (ks * 64 + lane) * 16);
#pragma unroll
                    for (int rt = kb; rt < 4; ++rt) acc[rt] = mfma16(*(const LAS bf16x8*)(ua + (16 * rt - 2 * ks) * 32), bfr, acc[rt]); }
#pragma unroll
            for (int kc = 0; kc < 4; ++kc) { const bf16x8 bfr = *(const LAS bf16x8*)(lds + 32768 + (kc * 64 + lane) * 16);
#pragma unroll
                for (int rt = 0; rt < 4; ++rt) { const LAS unsigned char* lp = lds + 36864 + ((rt * 4 + kc) * 2 * 64 + lane) * 16;
                    const f32x4 l01 = *(const LAS f32x4*)lp, l23 = *(const LAS f32x4*)(lp + 1024); const f32x4 s01 = sv[kc][0], s23 = sv[kc][1];
                    const bf16x8 afv = __builtin_bit_cast(bf16x8, (u32x4){
                        cvt_pk_bf16(l01[0] * s01[0] - l01[1] * s01[1], l01[0] * s01[1] + l01[1] * s01[0]), cvt_pk_bf16(l01[2] * s01[2] - l01[3] * s01[3], l01[2] * s01[3] + l01[3] * s01[2]),
                        cvt_pk_bf16(l23[0] * s23[0] - l23[1] * s23[1], l23[0] * s23[1] + l23[1] * s23[0]), cvt_pk_bf16(l23[2] * s23[2] - l23[3] * s23[3], l23[2] * s23[3] + l23[3] * s23[2])});
                    acc[rt] = mfma16(afv, bfr, acc[rt]); } }
            const float dk = dsk[g * GS + row];
#pragma unroll
            for (int rt = 0; rt < 4; ++rt)
#pragma unroll
                for (int r = 0; r < 4; ++r) { const int tl = 16 * rt + 4 * kq + r, t = t0 + tl;
                    const float uu = bf2f(*(const LAS bf16_t*)(Uw + 2048 + tl * 32 + row * 2));
#if DBG == 1
                    ((bf16_t*)(ws + WS_DBGA))[(size_t)t * SSMW + g * GS + row] = (bf16_t)f2bf(acc[rt][r] * 64.f);
#endif
                    yssm[(size_t)t * SSMW + g * GS + row] = (bf16_t)f2bf(gelu_tanh(acc[rt][r] + dk * uu)); }
            asm volatile("s_waitcnt lgkmcnt(0)" ::: "memory"); __builtin_amdgcn_wave_barrier();
        }
        {
            const bf16_t* opart = (const bf16_t*)(ws + WS_OPART); const float* mpart = (const float*)(ws + WS_MPART); const float* lpart = (const float*)(ws + WS_LPART);
            for (int i = bx * 512 + tid; i < T * AH * 8; i += G * 512) { const int th = i >> 3, c8 = (i & 7) * 8, t = th / AH, h = th % AH;
                float m[3], l[3]; u32x4 o[3];
#pragma unroll
                for (int pp = 0; pp < 3; ++pp) { m[pp] = mpart[((size_t)pp * T + t) * AH + h]; l[pp] = lpart[((size_t)pp * T + t) * AH + h]; o[pp] = *(const u32x4*)(opart + ((size_t)pp * T + t) * AW + h * HD + c8); }
                const float M = fmaxf(m[0], fmaxf(m[1], m[2]));
                float w0 = l[0] * exp2f(m[0] - M), w1 = l[1] * exp2f(m[1] - M), w2 = l[2] * exp2f(m[2] - M);
                const float rw = 1.f / (w0 + w1 + w2); w0 *= rw; w1 *= rw; w2 *= rw;
                f32x4 a0, a1, b0, b1, c0, c1; unpack8(o[0], a0, a1); unpack8(o[1], b0, b1); unpack8(o[2], c0, c1);
                *(u32x4*)(concat + (size_t)t * D + SSMW + h * HD + c8) = pack8(a0 * w0 + b0 * w1 + c0 * w2, a1 * w0 + b1 * w1 + c1 * w2);
            }
        }
        { constexpr int I_EXP = 768; LAS float* scr = (LAS float*)(lds + wave * 16384);
          __syncthreads();
          EXPERT_ITEMS(gw, NGW, 0, 0, 0); }
#if DBG == 1
        if (wave == 0 && bx < NB * NG) {
            const int b = bx / NG, g = bx % NG, p = lane;
            const float* a_re = args.in[4]; const float* a_im = args.in[5]; const float* b_re = args.in[6]; const float* b_im = args.in[7];
            const float* c_re = args.in[8]; const float* c_im = args.in[9]; const float* logstep = args.in[11];
            const float lre = a_re[g * NS + p], lim = a_im[g * NS + p], step = expf(logstep[g]);
            const float er = expf(lre * step), lbr = er * cosf(lim * step), lbi = er * sinf(lim * step);
            const float nr = lbr - 1.f, ni = lbi, den = lre * lre + lim * lim;
            const float fr_ = (nr * lre + ni * lim) / den, fi_ = (ni * lre - nr * lim) / den;
            float bbr[GS], bbi[GS], cr[GS], ci[GS];
#pragma unroll
            for (int h = 0; h < GS; ++h) {
                const float xr = b_re[((size_t)g * NS + p) * GS + h], xi = b_im[((size_t)g * NS + p) * GS + h];
                bbr[h] = fr_ * xr - fi_ * xi; bbi[h] = fr_ * xi + fi_ * xr;
                cr[h] = c_re[((size_t)g * GS + h) * NS + p]; ci[h] = c_im[((size_t)g * GS + h) * NS + p];
            }
            float sr = 0.f, si = 0.f;
            for (int t = 0; t < S; ++t) {
                const u32x4* up = (const u32x4*)((const bf16_t*)(ws + WS_UG) + ((size_t)(g * NB + b) * S + t) * GS);
                f32x4 u0, u1, u2, u3; unpack8(up[0], u0, u1); unpack8(up[1], u2, u3);
                const float u[GS] = {u0[0], u0[1], u0[2], u0[3], u1[0], u1[1], u1[2], u1[3], u2[0], u2[1], u2[2], u2[3], u3[0], u3[1], u3[2], u3[3]};
                float br = 0.f, bi = 0.f;
#pragma unroll
                for (int h = 0; h < GS; ++h) { br += bbr[h] * u[h]; bi += bbi[h] * u[h]; }
                const float nsr = lbr * sr - lbi * si + br, nsi = lbr * si + lbi * sr + bi;
                sr = nsr; si = nsi;
                float mine = 0.f;
#pragma unroll
                for (int h = 0; h < GS; ++h) { const float v = wave_sum(cr[h] * sr - ci[h] * si); if (p == h) mine = v; }
                if (p < GS) ((bf16_t*)(ws + WS_DBGB))[(size_t)(b * S + t) * SSMW + g * GS + p] = (bf16_t)f2bf(mine * 64.f);
            }
        }
#endif
        SEAM(PH_SSMY);
    }

    if (IN(PH_GLU)) { PH_ENTER
#if DBG
        {
            const bf16_t* A = (const bf16_t*)(ws + WS_DBGA); const bf16_t* B = (const bf16_t*)(ws + WS_DBGB);
            float* acc = (float*)(ctl + CW_DBG);
            const size_t n = (DBG == 1) ? (size_t)T * SSMW : (size_t)T * AW;
            float num = 0.f, den = 0.f;
            if (DBG == 1) { for (size_t i = (size_t)bx * 512 + tid; i < n; i += (size_t)G * 512) { const float a = bf2f(A[i]), b = bf2f(B[i]); num += (a - b) * (a - b); den += b * b; } }
            else { for (size_t i = (size_t)bx * 512 + tid; i < n; i += (size_t)G * 512) { const size_t t = i / AW, c = i % AW; const float a = bf2f(A[i]), b = bf2f(concat[t * D + SSMW + c]); num += (a - b) * (a - b); den += a * a; } }
            num = wave_sum(num); den = wave_sum(den);
            if (lane == 0) { atomicAdd(acc, num); atomicAdd(acc + 1, den); }
        }
#endif
        SchedPlain Sd{T / BM, GLUN / BM, G, bx, SSMW, (const char*)(ws + WS_WGLU), 2};
        EpiGlu E{yssm, concat, args.in[13]};
        gemm_phase<EpiGlu, SchedPlain, true, true>(lds, tid, (const char*)yssm, SSMW, Sd, E);
        { constexpr int I_EXP = 768; LAS float* scr = (LAS float*)(lds + wave * 16384); const int nu = (T / BM) * (GLUN / BM);
          __syncthreads();
          if (nu >= G) { DENSE_ITEMS(gw, NGW, 1096, 1608); EXPERT_ITEMS(gw, NGW, IT_GU - FILL_GLU, IT_GU, 0); }
          else if (bx >= nu) { DENSE_ITEMS((bx - nu) * 8 + wave, (G - nu) * 8, 1096, 1608); EXPERT_ITEMS((bx - nu) * 8 + wave, (G - nu) * 8, IT_GU - FILL_GLU, IT_GU, 0); } }
        SEAM(PH_GLU);
    }

    if (IN(PH_OUT0)) { PH_ENTER
        SchedPlain Sd{T / BM, D / BM, G, bx, D, (const char*)(ws + WS_WOUT0), 2};
        EpiResid E{hb, ws + WS_HB8};
        gemm_phase<EpiResid, SchedPlain, true, true>(lds, tid, (const char*)concat, D, Sd, E);
        SEAM(PH_OUT0);
    }

    for (int layer = 0; layer < 2; ++layer) {
        const int pb = (layer == 0) ? PH_RT0 : PH_RT1;
        if (IN(pb)) { PH_ENTER
            int* cnt = (int*)(ctl + CW_CNT) + layer * 4096;
#if DRY_MASK
            if (args.dry) { cnt += 8192; list = (int*)(ws + 256 * MiB); gatel = (float*)(ws + 260 * MiB); tokrow = (int*)(ws + 264 * MiB); rs_ffn = (float*)(ws + 266 * MiB); }
#endif
            const float* brg = args.in[21] + layer * 4; const float* bre = args.in[23] + layer * NE;
            const bf16_t* wrt = (const bf16_t*)(ws + WS_WRT) + (size_t)layer * 2 * 48 * D;
            const int row = lane & 15, kq = lane >> 4;
            const int cv0 = layer == 0 ? 0 : IT_LAYER + FILL_G2, cv1 = layer == 0 ? IT_GU - FILL_IN - FILL_GLU : IT_LAYER + IT_GU;
            const int cvm = cv0 + (cv1 - cv0) * RT_SPLIT / 16;
            for (int task = bx; task < T / 64; task += G) {
                const int t0 = task * 64; const bool first = task == bx;
                if (wave < 4) {
                    LAS float* L = (LAS float*)(lds + wave * 12544);
#pragma unroll 1
                    for (int half = 0; half < 2; ++half) {
                        const int k0 = 256 * wave + 128 * half;
                        const bf16_t* bp = wrt + (size_t)row * D + k0 + 8 * kq;
                        bf16x8 bh[3][4], bl[3][4];
#pragma unroll
                        for (int nt = 0; nt < 3; ++nt)
#pragma unroll
                            for (int ks = 0; ks < 4; ++ks) { bh[nt][ks] = *(const bf16x8*)(bp + (size_t)nt * 16 * D + 32 * ks); bl[nt][ks] = *(const bf16x8*)(bp + (size_t)(48 + nt * 16) * D + 32 * ks); }
#pragma unroll
                        for (int rt = 0; rt < 4; ++rt) {
                            const bf16_t* ap = hb + (size_t)(t0 + 16 * rt + row) * D + k0 + 8 * kq;
                            u32x4 a[4];
#pragma unroll
                            for (int ks = 0; ks < 4; ++ks) a[ks] = *(const u32x4*)(ap + 32 * ks);
                            f32x4 acc[3] = {(f32x4){0.f, 0.f, 0.f, 0.f}, (f32x4){0.f, 0.f, 0.f, 0.f}, (f32x4){0.f, 0.f, 0.f, 0.f}};
                            float ss = 0.f;
#pragma unroll
                            for (int ks = 0; ks < 4; ++ks) { f32x4 x0, x1; unpack8(a[ks], x0, x1);
                                ss += ((x0[0] * x0[0] + x0[1] * x0[1]) + (x0[2] * x0[2] + x0[3] * x0[3])) + ((x1[0] * x1[0] + x1[1] * x1[1]) + (x1[2] * x1[2] + x1[3] * x1[3]));
                                const bf16x8 af = __builtin_bit_cast(bf16x8, a[ks]);
#pragma unroll
                                for (int nt = 0; nt < 3; ++nt) { acc[nt] = mfma16(af, bh[nt][ks], acc[nt]); acc[nt] = mfma16(af, bl[nt][ks], acc[nt]); } }
                            ss += shx(ss, 16, lane); ss += shx(ss, 32, lane);
#pragma unroll
                            for (int nt = 0; nt < 3; ++nt)
#pragma unroll
                                for (int r = 0; r < 4; ++r) { LAS float* lp = L + (16 * rt + 4 * kq + r) * 48 + nt * 16 + row; *lp = half ? *lp + acc[nt][r] : acc[nt][r]; }
                            if (lane < 16) { LAS float* lp = L + 3072 + 16 * rt + lane; *lp = half ? *lp + ss : ss; }
                        }
                    }
                } else if (first) { LAS float* scr = (LAS float*)(lds + 65536 + (wave - 4) * 16384);
                    EXPERT_ITEMS(bx * 4 + wave - 4, G * 4, cv0, cvm, 0); }
                __syncthreads();
                if (wave != 0 && first) { LAS float* scr = (LAS float*)(lds + 53248 + (wave - 1) * 8704);
                    EXPERT_ITEMS(bx * 7 + wave - 1, G * 7, cvm, cv1, 0); }
                if (tid < 64) { const int t = t0 + tid;
                    float lg[36]; float sq = 0.f;
#pragma unroll
                    for (int j = 0; j < 36; ++j) lg[j] = 0.f;
#pragma unroll
                    for (int w = 0; w < 4; ++w) { const LAS float* Lw = (const LAS float*)(lds + w * 12544); sq += Lw[3072 + tid];
#pragma unroll
                        for (int j = 0; j < 36; ++j) lg[j] += Lw[tid * 48 + j]; }
                    const float r = rsqrtf(sq * (1.f / D) + EPS);
                    rs_ffn[t] = r;
                    LAS float* Lr = (LAS float*)lds + tid * 48;
#pragma unroll
                    for (int j = 0; j < 36; ++j) Lr[j] = lg[j];
                    float mg = -INFINITY; int gi = 0;
                    for (int j = 0; j < 4; ++j) { const float v = Lr[j] * r + brg[j]; if (v > mg) { mg = v; gi = j; } }
                    float sg = 0.f; for (int j = 0; j < 4; ++j) sg += expf(Lr[j] * r + brg[j] - mg);
                    const float gwt = 1.f / sg;
                    int i1 = 0; float m1 = -INFINITY;
                    for (int j = 0; j < 8; ++j) { const float v = Lr[4 + gi * 8 + j] * r + bre[gi * 8 + j]; if (v > m1) { m1 = v; i1 = j; } }
                    int i2 = 0; float m2 = -INFINITY;
                    for (int j = 0; j < 8; ++j) { const float v = Lr[4 + gi * 8 + j] * r + bre[gi * 8 + j]; if (j != i1 && v > m2) { m2 = v; i2 = j; } }
                    const float p2 = expf(m2 - m1);
                    const float g1 = gwt / (1.f + p2), g2 = gwt * p2 / (1.f + p2);
                    const int e1 = gi * 8 + i1, e2 = gi * 8 + i2;
                    LAS int* lc = (LAS int*)(lds + 4 * 12544); LAS int* lb = lc + 32;
                    if (tid < 32) lc[tid] = 0;
                    asm volatile("s_waitcnt lgkmcnt(0)" ::: "memory"); __builtin_amdgcn_wave_barrier();
                    const int q1 = __hip_atomic_fetch_add(&lc[e1], 1, __ATOMIC_RELAXED, __HIP_MEMORY_SCOPE_WORKGROUP);
                    const int q2 = __hip_atomic_fetch_add(&lc[e2], 1, __ATOMIC_RELAXED, __HIP_MEMORY_SCOPE_WORKGROUP);
                    asm volatile("s_waitcnt lgkmcnt(0)" ::: "memory"); __builtin_amdgcn_wave_barrier();
                    if (tid < 32) { const int n = lc[tid]; lb[tid] = n > 0 ? atomicAdd(&cnt[64 * tid], n) : 0; }
                    asm volatile("s_waitcnt vmcnt(0) lgkmcnt(0)" ::: "memory"); __builtin_amdgcn_wave_barrier();
                    const int s1 = lb[e1] + q1, s2 = lb[e2] + q2;
                    list[(size_t)e1 * CAP + s1] = t; gatel[(size_t)e1 * CAP + s1] = g1;
                    list[(size_t)e2 * CAP + s2] = t; gatel[(size_t)e2 * CAP + s2] = g2;
                    tokrow[t * 4 + 0] = e1; tokrow[t * 4 + 1] = s1; tokrow[t * 4 + 2] = e2; tokrow[t * 4 + 3] = s2;
                }
                __syncthreads();
            }
            SEAM(pb);
        }
        if (IN(pb + 1) || IN(pb + 2)) { PH_ENTER
            int* cnt = (int*)(ctl + CW_CNT) + layer * 4096;
            LAS int* tile_e = (LAS int*)(lds + TAB_TILE_E); LAS int* tile_m = (LAS int*)(lds + TAB_TILE_M); LAS int* ntp = (LAS int*)(lds + TAB_NT);
            LAS int* tokT = (LAS int*)(lds + TAB_TOK); LAS float* gateT = (LAS float*)(lds + TAB_GATE);
            __syncthreads();
            LAS int* cntL = (LAS int*)(lds + TAB_NT + 16);
            if (tid < 64) { const int e = lane & 31; const int c = __hip_atomic_load(&cnt[64 * e], __ATOMIC_RELAXED, __HIP_MEMORY_SCOPE_AGENT); const int mt = (c + 255) >> 8;
                int inc = mt;
#pragma unroll
                for (int o = 1; o < 32; o <<= 1) { const int v = bperm(lane - o, inc); if (e >= o) inc += v; }
                if (tid < 32) { cntL[e] = c; const int st = inc - mt; for (int j = 0; j < mt; ++j) { tile_e[st + j] = e; tile_m[st + j] = j; } if (e == 31) *ntp = inc; } }
            __syncthreads();
            const int ntiles = *ntp;
            for (int i = 0; i < 4; ++i) { const int L = i * G + bx; if (L >= ntiles * 4) break;
                int pm, pn; unit_map(L, ntiles, 4, pm, pn); const int e = tile_e[pm], tm = tile_m[pm];
                const int c = cntL[e];
                if (tid < 256) { const int idx = tm * 256 + tid; const bool ok = idx < c;
                    tokT[i * 256 + tid] = ok ? list[(size_t)e * CAP + idx] : 0; gateT[i * 256 + tid] = ok ? gatel[(size_t)e * CAP + idx] : 0.f; } }
            __syncthreads();
            if (IN(pb + 1)) {
                {
                    SchedMoe Sd{ntiles, 4, G, bx, D, (const char*)(ws + WS_WGU + (size_t)layer * WS_MOE_LAYER), (size_t)D * D, tile_e, tokT, tile_m, cntL, 1};
                    EpiMoe1F8 E{(unsigned char*)Hb, rs_ffn, tokT};
                    gemm_phase8<EpiMoe1F8, SchedMoe>(lds, wv0 * 64 + lane_now(), (const char*)(ws + WS_HB8), D, Sd, E, F8_SCALE_WGU);
                }
                {
                    LAS float* scr = (LAS float*)(lds + wave * 16384); const int r = (ntiles * 4) % G;
                    const int dn0 = layer * IT_LAYER + IT_GU, dn1 = dn0 + IT_DN, de0 = layer == 0 ? 1608 : 0, de1 = layer == 0 ? 3656 : 0;
                    __syncthreads();
                    if (r == 0) { DENSE_ITEMS(gw, NGW, de0, de1); EXPERT_ITEMS(gw, NGW, dn0, dn1, 0); }
                    else if (bx >= r) { DENSE_ITEMS((bx - r) * 8 + wave, (G - r) * 8, de0, de1); EXPERT_ITEMS((bx - r) * 8 + wave, (G - r) * 8, dn0, dn1, 0); } }
                SEAM(pb + 1);
            }
            if (IN(pb + 2)) {
                {
                    SchedMoe Sd{ntiles, 4, G, bx, DE, (const char*)(ws + WS_WD + (size_t)layer * WS_MOE_LAYER), (size_t)D * DE, tile_e, nullptr, tile_m, cntL, 1};
                    EpiMoe2 E{(unsigned char*)Yb, gateT};
                    gemm_phase8<EpiMoe2, SchedMoe>(lds, wv0 * 64 + lane_now(), (const char*)Hb, DE, Sd, E, F8_SCALE_WD);
                }
                if (layer == 0) {
                    LAS float* scr = (LAS float*)(lds + wave * 16384); const int r = (ntiles * 4) % G;
                    __syncthreads();
                    if (r == 0) EXPERT_ITEMS(gw, NGW, IT_LAYER, IT_LAYER + FILL_G2, 1);
                    else if (bx >= r) EXPERT_ITEMS((bx - r) * 8 + wave, (G - r) * 8, IT_LAYER, IT_LAYER + FILL_G2, 1); }
                SEAM(pb + 2);
            }
        }
        if (IN(pb + 3)) { PH_ENTER
            int* cnt = (int*)(ctl + CW_CNT) + layer * 4096;
            __syncthreads();
            LAS int* pst = (LAS int*)(lds + TAB_TILE_E);
            if (tid < 64) { const int e = lane & 31; const int c = __hip_atomic_load(&cnt[64 * e], __ATOMIC_RELAXED, __HIP_MEMORY_SCOPE_AGENT); const int mt = (c + 255) >> 8;
                int inc = mt;
#pragma unroll
                for (int o = 1; o < 32; o <<= 1) { const int v = bperm(lane - o, inc); if (e >= o) inc += v; }
                if (tid < 32) pst[e] = (inc - mt) << 8; }
            __syncthreads();
            int myr1 = 0, myr2 = 0;
            { const int t = gw + lane * NGW; if (t < T) { const int4 tr = *(const int4*)(tokrow + t * 4); myr1 = pst[tr.x] + tr.y; myr2 = pst[tr.z] + tr.w; } }
            for (int k0 = 0, t0 = gw; t0 < T; k0 += 4, t0 += 4 * NGW) {
                unsigned ya[4][4], yb[4][4]; u32x2 hc[4][4];
#pragma unroll
                for (int q = 0; q < 4; ++q) { const int tq = t0 + q * NGW, tc = tq < T ? tq : t0;
                    const int r1 = __builtin_amdgcn_readlane(myr1, k0 + q), r2 = __builtin_amdgcn_readlane(myr2, k0 + q);
                    const u32x2* hr = (const u32x2*)(hb + (size_t)tc * D) + lane; const unsigned* y1 = (const unsigned*)((const unsigned char*)Yb + (size_t)r1 * D) + lane; const unsigned* y2 = (const unsigned*)((const unsigned char*)Yb + (size_t)r2 * D) + lane;
#pragma unroll
                    for (int j = 0; j < 4; ++j) { ya[q][j] = y1[64 * j]; yb[q][j] = y2[64 * j]; hc[q][j] = hr[64 * j]; } }
#pragma unroll
                for (int q = 0; q < 4; ++q) { const int t = t0 + q * NGW; if (t >= T) break;
                    u32x2* hr = (u32x2*)(hb + (size_t)t * D) + lane;
                    float s = 0.f; f32x4 v[4];
#pragma unroll
                    for (int j = 0; j < 4; ++j) { const u32x2 c = hc[q][j]; f32x4 hv;
                        const f32x2 a0 = __builtin_amdgcn_cvt_pk_f32_fp8((int)ya[q][j], false), a1 = __builtin_amdgcn_cvt_pk_f32_fp8((int)ya[q][j], true), b0 = __builtin_amdgcn_cvt_pk_f32_fp8((int)yb[q][j], false), b1 = __builtin_amdgcn_cvt_pk_f32_fp8((int)yb[q][j], true);
                        hv.x = bf_lo(c.x) + (a0[0] + b0[0]) * 0.0625f; hv.y = bf_hi(c.x) + (a0[1] + b0[1]) * 0.0625f; hv.z = bf_lo(c.y) + (a1[0] + b1[0]) * 0.0625f; hv.w = bf_hi(c.y) + (a1[1] + b1[1]) * 0.0625f;
                        v[j] = hv; s += (hv.x * hv.x + hv.y * hv.y) + (hv.z * hv.z + hv.w * hv.w); }
                    if (layer == 0) {
                        s = wave_sum_l(s, lane);
                        if (lane == 0) rs_mix[t] = rsqrtf(s * (1.f / D) + EPS);
#pragma unroll
                        for (int j = 0; j < 4; ++j) hr[64 * j] = (u32x2){cvt_pk_bf16(v[j].x, v[j].y), cvt_pk_bf16(v[j].z, v[j].w)};
                    } else {
                        f32x4* ho = (f32x4*)(hout + (size_t)t * D) + lane;
#pragma unroll
                        for (int j = 0; j < 4; ++j) __builtin_nontemporal_store(v[j], ho + 64 * j); }
                }
            }
            if (layer == 0) SEAM(pb + 3);
        }
        if (layer == 0) {
            if (IN(PH_CONVIN)) { PH_ENTER
                SchedPlain Sd{T / BM, CONVN / BM, G, bx, D, (const char*)(ws + WS_WINC), 2};
                EpiConvIn E{bgate, zcb, rs_mix};
                gemm_phase<EpiConvIn, SchedPlain, true, true>(lds, tid, (const char*)hb, D, Sd, E);
                SEAM(PH_CONVIN);
            }
            if (IN(PH_CONV)) { PH_ENTER
                const float* cw = args.in[18];
                const int c8 = ((bx * 512 + tid) & 127) * 8;
                f32x4 w0[3], w1[3];
#pragma unroll
                for (int k = 0; k < 3; ++k) { w0[k] = *(const f32x4*)(cw + k * D + c8); w1[k] = *(const f32x4*)(cw + k * D + c8 + 4); }
                for (int sl = (bx * 512 + tid) >> 7; sl < T / 16; sl += (G * 512) >> 7) { const int tg0 = sl * 16;
                    u32x4 zr[18], br[16];
#pragma unroll
                    for (int j = 0; j < 18; ++j) { const int tg = tg0 - 2 + j; zr[j] = __builtin_nontemporal_load((const u32x4*)(zcb + (size_t)(tg < 0 ? 0 : tg) * D + c8)); }
#pragma unroll
                    for (int j = 0; j < 16; ++j) br[j] = __builtin_nontemporal_load((const u32x4*)(bgate + (size_t)(tg0 + j) * D + c8));
                    if ((tg0 % S) == 0) { zr[0] = (u32x4){0u, 0u, 0u, 0u}; zr[1] = zr[0]; }
#pragma unroll
                    for (int j = 0; j < 16; ++j) { f32x4 a0 = (f32x4){0.f, 0.f, 0.f, 0.f}, a1 = a0;
#pragma unroll
                        for (int k = 0; k < 3; ++k) { f32x4 z0, z1; unpack8(zr[j + k], z0, z1); a0 += w0[k] * z0; a1 += w1[k] * z1; }
                        f32x4 b0, b1; unpack8(br[j], b0, b1);
                        *(u32x2*)((unsigned char*)g2b + (size_t)(tg0 + j) * D + c8) = pack8_fp8(b0 * a0, b1 * a1); }
                }
                SEAM(PH_CONV);
            }
            if (IN(PH_CONVOUT)) { PH_ENTER
                SchedPlain Sd{T / BM, D / BM, G, bx, D, (const char*)(ws + WS_WOUTC), 1};
                EpiResid E{hb, ws + WS_HB8};
                gemm_phase8<EpiResid, SchedPlain>(lds, tid, (const char*)g2b, D, Sd, E, F8_SCALE_WGU);
                SEAM(PH_CONVOUT);
            }
        }
    }
#if DBG
    if (IN(NPHASE - 1)) { PH_ENTER
        xcd_barrier(bar);
        float* acc = (float*)(ctl + CW_DBG);
        const float fn = __hip_atomic_load(acc, __ATOMIC_RELAXED, __HIP_MEMORY_SCOPE_AGENT), fd = __hip_atomic_load(acc + 1, __ATOMIC_RELAXED, __HIP_MEMORY_SCOPE_AGENT);
        if (!(fn <= DBG_TOL * fd) && bx == 0) hout[tid] = __builtin_nanf("");
    }
#endif
#undef IN
#undef SEAM
}
}

extern "C" void kernel_launch(void* const* d_in, const int* in_sizes, int n_in, void* d_out, int out_size, void* d_ws, size_t ws_size, hipStream_t stream) {
    static int grid = 0;
    if (grid == 0) {
        if (n_in != 27 || out_size != T * D || ws_size < WS_END) { fprintf(stderr, "kernel_launch: unexpected shapes (n_in %d out %d ws %zu)\n", n_in, out_size, ws_size); grid = -1; return; }
        int dev = 0, cus = 0, per_cu = 0;
        if (hipGetDevice(&dev) != hipSuccess || hipDeviceGetAttribute(&cus, hipDeviceAttributeMultiprocessorCount, dev) != hipSuccess) { grid = -1; return; }
        if (hipFuncSetAttribute((const void*)fwd, hipFuncAttributeMaxDynamicSharedMemorySize, LDS_BYTES) != hipSuccess) { fprintf(stderr, "kernel_launch: hipFuncSetAttribute failed\n"); grid = -1; return; }
        if (hipOccupancyMaxActiveBlocksPerMultiprocessor(&per_cu, (const void*)fwd, 512, LDS_BYTES) != hipSuccess || per_cu < 1) { fprintf(stderr, "kernel_launch: occupancy query says %d\n", per_cu); }
        (void)hipGetLastError();
        grid = cus;
    }
    if (grid < 0) return;
    (void)hipMemsetAsync((char*)d_ws + WS_CTL, 0, CTL_BYTES, stream);
    Args a{};
    for (int i = 0; i < 27; ++i) a.in[i] = (const float*)d_in[i];
    a.out = (float*)d_out; a.ws = (unsigned char*)d_ws;
    if (NLAUNCH == 1) { a.ph_lo = 0; a.ph_hi = NPHASE; hipLaunchKernelGGL(fwd, dim3(grid), dim3(512), LDS_BYTES, stream, a); }
    else for (int p = 0; p < NPHASE; ++p) { a.ph_lo = p; a.ph_hi = p + 1;
        if ((DRY_MASK >> p) & 1u) { a.dry = DRY_KIND; hipLaunchKernelGGL(fwd, dim3(grid), dim3(512), LDS_BYTES, stream, a); a.dry = 0; }
        const int reps = ((REPEAT_MASK >> p) & 1u) ? 2 : 1;
        for (int r = 0; r < reps; ++r) hipLaunchKernelGGL(fwd, dim3(grid), dim3(512), LDS_BYTES, stream, a); }
}
```
